# Optimizing an MI355X kernel written in HIP

```python
import math
import jax
import jax.numpy as jnp
from jax import lax
import numpy as np

D_MODEL = 1024
BATCH = 4
SEQ = 4096
DEPTH = 1

GLA_HEADS = 4
GLA_DK = 128
GLA_DV = 256
GLA_GATE_RANK = 16
GLA_TAU = 16.0
GLA_CHUNK = 64
NSA_HEADS = 8
NSA_GROUPS = 2
NSA_REP = NSA_HEADS // NSA_GROUPS
NSA_DH = 64
NSA_CMP_LEN = 32
NSA_CMP_STRIDE = 16
NSA_SLC_LEN = 64
NSA_N_SEL = 16
NSA_WINDOW = 512
NSA_Q_BLOCK = 128
D_FF = 2816
RMS_EPS = 1e-6
NEG = -1e30

GLA_QK_W = GLA_HEADS * GLA_DK
GLA_V_W = GLA_HEADS * GLA_DV
NSA_Q_W = NSA_HEADS * NSA_DH
NSA_KV_W = NSA_GROUPS * NSA_DH
NSA_GATE_W = NSA_HEADS * 3
IN_SPLITS = (GLA_QK_W, GLA_QK_W, GLA_V_W, GLA_V_W, GLA_GATE_RANK,
             NSA_Q_W, NSA_KV_W, NSA_KV_W, NSA_KV_W, NSA_KV_W, NSA_KV_W, NSA_KV_W,
             NSA_GATE_W, D_MODEL, D_MODEL)
IN_WIDTH = 4 * GLA_QK_W // 2 + 2 * GLA_V_W + GLA_GATE_RANK + NSA_Q_W + 6 * NSA_KV_W + NSA_GATE_W + 2 * D_MODEL

kernel_name = 'gla_nsa_hybrid_block'


def rms_norm(x, g):
    xf = x.astype(jnp.float32)
    y = xf * lax.rsqrt(jnp.mean(xf * xf, axis=-1, keepdims=True) + RMS_EPS)
    return (y * g.astype(jnp.float32)).astype(x.dtype)


def masked_softmax(s, mask):
    s = jnp.where(mask, s, NEG)
    p = jax.nn.softmax(s, axis=-1)
    return jnp.where(mask, p, 0.0)


def gla_mixer(q, k, v, r, a_lr, w_alpha2, b_alpha, norm_g):
    B, S = q.shape[0], q.shape[1]
    C = GLA_CHUNK
    nc = S // C

    def heads(t, d):
        return t.reshape(B, nc, C, GLA_HEADS, d).transpose(0, 3, 1, 2, 4).astype(jnp.float32)

    qh = heads(q, GLA_DK) * (GLA_DK ** -0.5)
    kh = heads(k, GLA_DK)
    vh = heads(v, GLA_DV)
    log_a = jax.nn.log_sigmoid((a_lr @ w_alpha2 + b_alpha).astype(jnp.float32)) / GLA_TAU
    b = jnp.cumsum(heads(log_a, GLA_DK), axis=3)
    b_last = b[:, :, :, -1:, :]
    qe = qh * jnp.exp(b)
    ke = kh * jnp.exp(-b)
    kd = kh * jnp.exp(b_last - b)
    causal = jnp.tril(jnp.ones((C, C), dtype=bool))
    attn = jnp.where(causal, jnp.einsum('bhncd,bhnsd->bhncs', qe, ke), 0.0)
    o = jnp.einsum('bhncs,bhnse->bhnce', attn, vh)
    upd = jnp.einsum('bhncd,bhnce->nbhde', kd, vh)
    decay = jnp.exp(b_last[:, :, :, 0, :]).transpose(2, 0, 1, 3)

    def step(state, inp):
        dec, u = inp
        return dec[..., None] * state + u, state

    init = jnp.zeros((B, GLA_HEADS, GLA_DK, GLA_DV), jnp.float32)
    _, s_prev = lax.scan(step, init, (decay, upd))
    o = o + jnp.einsum('bhncd,nbhde->bhnce', qe, s_prev)
    o = o * lax.rsqrt(jnp.mean(o * o, axis=-1, keepdims=True) + RMS_EPS) * norm_g.astype(jnp.float32)
    o = o.reshape(B, GLA_HEADS, S, GLA_DV).transpose(0, 2, 1, 3).reshape(B, S, GLA_V_W)
    return (o * jax.nn.silu(r.astype(jnp.float32))).astype(r.dtype)


def nsa_mixer(q, k_c, v_c, k_s, v_s, k_w, v_w, gate_logits, pe_k, w1_k, w2_k, pe_v, w1_v, w2_v):
    B, S = q.shape[0], q.shape[1]
    G, R, DH = NSA_GROUPS, NSA_REP, NSA_DH
    L, ST, SL, QB, W = NSA_CMP_LEN, NSA_CMP_STRIDE, NSA_SLC_LEN, NSA_Q_BLOCK, NSA_WINDOW
    qh = q.reshape(B, S, G, R, DH).transpose(0, 2, 3, 1, 4).astype(jnp.float32) * (DH ** -0.5)

    def kv_heads(t):
        return t.reshape(B, S, G, DH).transpose(0, 2, 1, 3).astype(jnp.float32)

    gates = jax.nn.sigmoid(gate_logits.astype(jnp.float32)).reshape(B, S, G, R, 3).transpose(0, 2, 3, 1, 4)
    h_idx = jnp.arange(NSA_HEADS, dtype=jnp.float32)
    slopes = jnp.exp2(-8.0 * (h_idx + 1.0) / NSA_HEADS).reshape(1, G, R, 1, 1)

    n_cmp = (S - L) // ST + 1
    starts_c = ST * jnp.arange(n_cmp)
    idx_c = starts_c[:, None] + jnp.arange(L)[None, :]

    def compress(t, pe, w1, w2):
        blocks = t[:, :, idx_c] + pe
        flat = blocks.reshape(B, G, n_cmp, L * DH)
        return jax.nn.silu(flat @ w1) @ w2

    kc = compress(kv_heads(k_c), pe_k, w1_k, w2_k).astype(jnp.float32)
    vc = compress(kv_heads(v_c), pe_v, w1_v, w2_v).astype(jnp.float32)
    end_c = starts_c + L - 1

    n_slc = S // SL
    n_sel = min(NSA_N_SEL, n_slc)
    starts_s = SL * jnp.arange(n_slc)
    ov = jnp.clip(jnp.minimum(starts_c[:, None] + L, starts_s[None, :] + SL)
                  - jnp.maximum(starts_c[:, None], starts_s[None, :]), 0, None).astype(jnp.float32) / L
    ks_blocks = kv_heads(k_s).reshape(B, G, n_slc, SL, DH)
    vs_blocks = kv_heads(v_s).reshape(B, G, n_slc, SL, DH)
    gather = jax.vmap(jax.vmap(lambda blk, ix: blk[ix]))

    kw_pad = jnp.pad(kv_heads(k_w), ((0, 0), (0, 0), (W, 0), (0, 0)))
    vw_pad = jnp.pad(kv_heads(v_w), ((0, 0), (0, 0), (W, 0), (0, 0)))

    nq = S // QB
    q_blocks = qh.reshape(B, G, R, nq, QB, DH).transpose(3, 0, 1, 2, 4, 5)
    g_blocks = gates.reshape(B, G, R, nq, QB, 3).transpose(3, 0, 1, 2, 4, 5)
    jb = jnp.arange(n_slc)
    r_w = jnp.arange(W + QB)

    def attend_block(args):
        i, qb, gb = args
        q0 = i * QB
        t = q0 + jnp.arange(QB)
        tf = t.astype(jnp.float32)
        dist_c = tf[:, None] - end_c[None, :].astype(jnp.float32)
        s_c = jnp.einsum('bgrqd,bgnd->bgrqn', qb, kc) - slopes * dist_c
        p_c = masked_softmax(s_c, end_c[None, :] <= t[:, None])
        o_c = jnp.einsum('bgrqn,bgnd->bgrqd', p_c, vc)
        imp = jnp.einsum('bgrqn,nj->bgqj', p_c, ov)
        cur = t // SL
        forced = (jb[None, :] == 0) | (jb[None, :] == cur[:, None]) | (jb[None, :] == cur[:, None] - 1)
        score = jnp.where(jb[None, :] > cur[:, None], NEG, jnp.where(forced, -NEG, imp))
        _, sel = lax.top_k(score, n_sel)
        ks = gather(ks_blocks, sel).reshape(B, G, QB, n_sel * SL, DH)
        vs = gather(vs_blocks, sel).reshape(B, G, QB, n_sel * SL, DH)
        pos_s = (sel[..., None] * SL + jnp.arange(SL)).reshape(B, G, QB, n_sel * SL)
        dist_s = (tf[None, None, :, None] - pos_s.astype(jnp.float32))[:, :, None]
        s_s = jnp.einsum('bgrqd,bgqkd->bgrqk', qb, ks) - slopes * dist_s
        p_s = masked_softmax(s_s, (pos_s <= t[None, None, :, None])[:, :, None])
        o_s = jnp.einsum('bgrqk,bgqkd->bgrqd', p_s, vs)
        kw = lax.dynamic_slice_in_dim(kw_pad, q0, W + QB, axis=2)
        vw = lax.dynamic_slice_in_dim(vw_pad, q0, W + QB, axis=2)
        pos_w = q0 - W + r_w
        dist_w = t[:, None] - pos_w[None, :]
        mask_w = (pos_w[None, :] >= 0) & (dist_w >= 0) & (dist_w < W)
        s_w = jnp.einsum('bgrqd,bgkd->bgrqk', qb, kw) - slopes * dist_w.astype(jnp.float32)
        p_w = masked_softmax(s_w, mask_w)
        o_w = jnp.einsum('bgrqk,bgkd->bgrqd', p_w, vw)
        return gb[..., 0:1] * o_c + gb[..., 1:2] * o_s + gb[..., 2:3] * o_w

    o = lax.map(attend_block, (jnp.arange(nq), q_blocks, g_blocks))
    return o.transpose(1, 0, 4, 2, 3, 5).reshape(B, S, NSA_Q_W).astype(q.dtype)


def setup_inputs(seed: int = 0) -> dict:
    key = jax.random.key(seed)
    ks = jax.random.split(key, 24)
    f32 = jnp.float32

    def normal(k, shape, fan_in):
        return jax.random.normal(k, shape, f32) * (fan_in ** -0.5)

    def gain(k, shape):
        return 1.0 + 0.1 * jax.random.normal(k, shape, f32)

    Ld = DEPTH
    return {
        'x': jax.random.normal(ks[0], (BATCH, SEQ, D_MODEL), f32),
        'norm_mix_pre': gain(ks[1], (Ld, D_MODEL)),
        'norm_mix_post': gain(ks[2], (Ld, D_MODEL)),
        'norm_ffn_pre': gain(ks[3], (Ld, D_MODEL)),
        'norm_ffn_post': gain(ks[4], (Ld, D_MODEL)),
        'w_in': normal(ks[5], (Ld, D_MODEL, IN_WIDTH), D_MODEL),
        'gla_w_alpha2': normal(ks[6], (Ld, GLA_GATE_RANK, GLA_QK_W), GLA_GATE_RANK),
        'gla_b_alpha': 0.1 * jax.random.normal(ks[7], (Ld, GLA_QK_W), f32),
        'gla_norm_g': gain(ks[8], (Ld, GLA_DV)),
        'nsa_cmp_pe_k': 0.1 * jax.random.normal(ks[9], (Ld, NSA_CMP_LEN, NSA_DH), f32),
        'nsa_cmp_w1_k': normal(ks[10], (Ld, NSA_CMP_LEN * NSA_DH, NSA_DH), NSA_CMP_LEN * NSA_DH),
        'nsa_cmp_w2_k': normal(ks[11], (Ld, NSA_DH, NSA_DH), NSA_DH),
        'nsa_cmp_pe_v': 0.1 * jax.random.normal(ks[12], (Ld, NSA_CMP_LEN, NSA_DH), f32),
        'nsa_cmp_w1_v': normal(ks[13], (Ld, NSA_CMP_LEN * NSA_DH, NSA_DH), NSA_CMP_LEN * NSA_DH),
        'nsa_cmp_w2_v': normal(ks[14], (Ld, NSA_DH, NSA_DH), NSA_DH),
        'w_proj_gla': normal(ks[15], (Ld, GLA_V_W, D_MODEL), GLA_V_W),
        'w_proj_nsa': normal(ks[16], (Ld, NSA_Q_W, D_MODEL), NSA_Q_W),
        'w_out': normal(ks[17], (Ld, D_MODEL, D_MODEL), D_MODEL),
        'w_ffn_gate': normal(ks[18], (Ld, D_MODEL, D_FF), D_MODEL),
        'w_ffn_up': normal(ks[19], (Ld, D_MODEL, D_FF), D_MODEL),
        'w_ffn_down': normal(ks[20], (Ld, D_FF, D_MODEL), D_FF),
    }


def reference(x, norm_mix_pre, norm_mix_post, norm_ffn_pre, norm_ffn_post, w_in,
              gla_w_alpha2, gla_b_alpha, gla_norm_g,
              nsa_cmp_pe_k, nsa_cmp_w1_k, nsa_cmp_w2_k, nsa_cmp_pe_v, nsa_cmp_w1_v, nsa_cmp_w2_v,
              w_proj_gla, w_proj_nsa, w_out, w_ffn_gate, w_ffn_up, w_ffn_down):
    split_points = [int(c) for c in np.cumsum(IN_SPLITS)[:-1]]
    for l in range(DEPTH):
        h = rms_norm(x, norm_mix_pre[l])
        proj = h @ w_in[l]
        (g_q, g_k, g_v, g_r, g_a, n_q, n_kc, n_vc, n_ks, n_vs, n_kw, n_vw,
         n_gate, merge_gla, merge_nsa) = jnp.split(proj, split_points, axis=-1)
        o_gla = gla_mixer(g_q, g_k, g_v, g_r, g_a, gla_w_alpha2[l], gla_b_alpha[l], gla_norm_g[l])
        o_nsa = nsa_mixer(n_q, n_kc, n_vc, n_ks, n_vs, n_kw, n_vw, n_gate,
                          nsa_cmp_pe_k[l], nsa_cmp_w1_k[l], nsa_cmp_w2_k[l],
                          nsa_cmp_pe_v[l], nsa_cmp_w1_v[l], nsa_cmp_w2_v[l])
        mixed = (jax.nn.sigmoid(merge_gla) * (o_gla @ w_proj_gla[l])
                 + jax.nn.sigmoid(merge_nsa) * (o_nsa @ w_proj_nsa[l]))
        x = x + rms_norm(mixed @ w_out[l], norm_mix_post[l])
        h = rms_norm(x, norm_ffn_pre[l])
        f = (jax.nn.silu(h @ w_ffn_gate[l]) * (h @ w_ffn_up[l])) @ w_ffn_down[l]
        x = x + rms_norm(f, norm_ffn_post[l])
    return x
```

```cpp
#include <hip/hip_runtime.h>
#include <hip/hip_cooperative_groups.h>
#include <cstdio>
#include <cstdint>
namespace cg = cooperative_groups;
#ifndef DIS
#define DIS 0
#endif
#ifndef DBL
#define DBL 0
#endif
namespace pg8 {
#define PG8_LAS __attribute__((address_space(3)))
typedef unsigned short bf16_t;
typedef short bf16x8 __attribute__((ext_vector_type(8)));
typedef float f32x4 __attribute__((ext_vector_type(4)));
typedef unsigned u32x4 __attribute__((ext_vector_type(4)));
constexpr int BM = 256, BK = 64, HALF = 128, HTB = HALF * BK * 2  , STAGE_BYTES = 8 * HTB, NXCD = 8, WGM = 8;

__host__ __device__ __forceinline__ int lds_byte(int r, int c) { const int st = (r >> 4) * 2 + (c >> 5), rr = r & 15, cc = c & 31, ob = rr * 64 + cc * 2; return st * 1024 + (ob ^ (((ob >> 9) & 1) << 5)); }
__host__ __device__ __forceinline__ void stage_rc(int b, int& R, int& C) { const int st = b / 1024, sb = b % 1024, swz = sb ^ (((sb >> 9) & 1) << 5); R = (st >> 1) * 16 + swz / 64; C = (st & 1) * 32 + (swz % 64) / 2; }
__host__ __device__ __forceinline__ int perm32(int rho) { const int n = rho >> 4, i = rho & 15; return 8 * (i >> 2) + 4 * n + (i & 3); }

struct Unit { int pm, pn; };
struct Gemm { const bf16_t* A; const bf16_t* Bt; int M, N, K; };

struct StaticOrder {
    int nM, nN, nwg, G, c;
    __host__ __device__ void init(int M, int N, int G_, int c_) { nM = M / BM; nN = N / BM; nwg = nM * nN; G = G_; c = c_; }
    __host__ __device__ bool next(int i, Unit& u) const {
        const long L = (long)i * G + c; if (L >= nwg) return false;
        int wgid = (int)L; { const int q = nwg / NXCD, r = nwg % NXCD, xcd = wgid % NXCD, off = wgid / NXCD; wgid = (xcd < r ? xcd * (q + 1) : r * (q + 1) + (xcd - r) * q) + off; }
        const int nig = WGM * nN, gid = wgid / nig, fm = gid * WGM, gsz = (nM - fm) < WGM ? (nM - fm) : WGM;
        u.pm = fm + ((wgid % nig) % gsz); u.pn = (wgid % nig) / gsz; return true;
    }
    __device__ __forceinline__ void a_ready(const Unit&) const {}
    __device__ __forceinline__ void done(const Unit&) const {}
};

__device__ __forceinline__ unsigned cvt_pk_bf16(float lo, float hi) { unsigned r; asm volatile("v_cvt_pk_bf16_f32 %0, %1, %2" : "=v"(r) : "v"(lo), "v"(hi)); return r; }
template <class Epi, class Sched, bool ALIGN_EPI = false, bool SP2 = false>
__device__ __forceinline__ void gemm_phase(PG8_LAS unsigned char* lds, const Gemm g, const Sched& S, const Epi& E, const int wid) {
    const int lane = (int)__builtin_amdgcn_mbcnt_hi(~0u, __builtin_amdgcn_mbcnt_lo(~0u, 0u)), tid = wid * 64 + lane, wr = wid >> 2, wc = wid & 3, fr = lane & 15, fq = lane >> 4;
    const int K = g.K, nt = K / BK;
    unsigned voffA[2], voffB[2];
#pragma unroll
    for (int i = 0; i < 2; ++i) { int R, C; stage_rc(tid * 16 + i * 8192, R, C); const int Rb = Epi::PERM ? ((R & ~31) + perm32(R & 31)) : R;
        voffA[i] = (unsigned)(R * K + C) * 2u; voffB[i] = (unsigned)(Rb * K + C) * 2u; }
    const size_t kstep = (size_t)(BK * 2);
    const size_t hstep = (size_t)HALF * K * 2;
    const size_t tstep = 2 * hstep;
    const unsigned ldsw = (unsigned)wid * 1024u;
    const int aoff = lds_byte(wr * 64 + fr, fq * 8), boff = lds_byte(wc * 32 + fr, fq * 8);
#define PG8_SA(b, h) (((b) * 2 + (h)) * HTB)
#define PG8_SB(b, h) ((4 + (b) * 2 + (h)) * HTB)
#define PG8_STAGE(bufoff, gbase, voff) do { _Pragma("unroll") for (int _i = 0; _i < 2; ++_i) \
        __builtin_amdgcn_global_load_lds((const unsigned*)((const char*)(gbase) + (voff)[_i]), (PG8_LAS unsigned*)(lds + (bufoff) + ldsw + _i * 8192), 16, 0, 0); } while (0)
#define PG8_LDA(dst, b, h) do { _Pragma("unroll") for (int m = 0; m < 4; ++m) _Pragma("unroll") for (int k = 0; k < 2; ++k) dst[m][k] = *(const PG8_LAS bf16x8*)(lds + PG8_SA(b, h) + aoff + m * 2048 + k * 1024); } while (0)
#define PG8_LDB(dst, b, h) do { _Pragma("unroll") for (int n = 0; n < 2; ++n) _Pragma("unroll") for (int k = 0; k < 2; ++k) dst[n][k] = *(const PG8_LAS bf16x8*)(lds + PG8_SB(b, h) + boff + n * 2048 + k * 1024); } while (0)
#define PG8_MMA(ai, bj, At, Bt) do { __builtin_amdgcn_s_setprio(1); _Pragma("unroll") for (int m = 0; m < 4; ++m) _Pragma("unroll") for (int n = 0; n < 2; ++n) _Pragma("unroll") for (int k = 0; k < 2; ++k) \
        acc[ai][bj][m][n] = __builtin_amdgcn_mfma_f32_16x16x32_bf16(Bt[n][k], At[m][k], acc[ai][bj][m][n], 0, 0, 0); __builtin_amdgcn_s_setprio(0); } while (0)
#define PG8_WAIT_V(n) asm volatile("s_waitcnt vmcnt(" #n ")" ::: "memory")
#define PG8_WAIT_L(n) asm volatile("s_waitcnt lgkmcnt(" #n ")" ::: "memory")
#define PG8_BAR __builtin_amdgcn_s_barrier()
#define PG8_SCHED __builtin_amdgcn_sched_barrier(0)
    Unit cur, nxt; int ui = 0;
    if (!S.next(0, cur)) return;
    f32x4 acc[2][2][4][2];
#pragma unroll
    for (int a = 0; a < 2; ++a)
#pragma unroll
        for (int b = 0; b < 2; ++b)
#pragma unroll
            for (int m = 0; m < 4; ++m)
#pragma unroll
                for (int n = 0; n < 2; ++n) acc[a][b][m][n] = (f32x4){0.f, 0.f, 0.f, 0.f};
    bf16x8 At[4][2], B0[2][2], B1[2][2];
    const char* cA = (const char*)g.A + (size_t)cur.pm * tstep; const char* cB = (const char*)g.Bt + (size_t)cur.pn * tstep;
    S.a_ready(cur);
    if constexpr (SP2) {
        PG8_STAGE(PG8_SB(0, 0), cB, voffB); PG8_STAGE(PG8_SB(0, 1), cB + hstep, voffB); PG8_STAGE(PG8_SA(0, 0), cA, voffA); PG8_STAGE(PG8_SA(0, 1), cA + hstep, voffA);
        if (wr == 1) PG8_BAR;
        PG8_WAIT_V(2); PG8_BAR;
        PG8_STAGE(PG8_SB(1, 0), cB + kstep, voffB); PG8_STAGE(PG8_SA(1, 0), cA + kstep, voffA); PG8_STAGE(PG8_SB(1, 1), cB + hstep + kstep, voffB);
        PG8_WAIT_V(6); PG8_BAR;
    } else {
        PG8_STAGE(PG8_SB(0, 0), cB, voffB); PG8_STAGE(PG8_SA(0, 0), cA, voffA); PG8_STAGE(PG8_SB(0, 1), cB + hstep, voffB); PG8_STAGE(PG8_SA(0, 1), cA + hstep, voffA);
        if (wr == 1) PG8_BAR;
        PG8_WAIT_V(4); PG8_BAR;
        PG8_STAGE(PG8_SB(1, 0), cB + kstep, voffB); PG8_STAGE(PG8_SA(1, 0), cA + kstep, voffA); PG8_STAGE(PG8_SB(1, 1), cB + hstep + kstep, voffB);
        PG8_WAIT_V(6); PG8_BAR;
    }
    for (;;) {
        const bool has_next = S.next(ui + 1, nxt);
        const char* nA = has_next ? (const char*)g.A + (size_t)nxt.pm * tstep : cA; const char* nB = has_next ? (const char*)g.Bt + (size_t)nxt.pn * tstep : cB;
        for (int t = 0; t < nt; t += 2) {
            if constexpr (Epi::MID_T >= 0) { if (t == Epi::MID_T) E.mid(acc, cur, wr, wc, fr, fq); }
            const bool last = (t == nt - 2);
            const char* a1 = cA + (size_t)(t + 1) * kstep;
            const char* a2 = last ? nA : cA + (size_t)(t + 2) * kstep; const char* b2 = last ? nB : cB + (size_t)(t + 2) * kstep;
            const char* a3 = a2 + kstep; const char* b3 = b2 + kstep;
            if (last && has_next) S.a_ready(nxt);
            if constexpr (SP2) {
            PG8_LDB(B0, 0, 0); PG8_LDB(B1, 0, 1); PG8_SCHED; PG8_LDA(At, 0, 0); PG8_STAGE(PG8_SA(1, 1), a1 + hstep, voffA);
            PG8_WAIT_V(8); PG8_WAIT_L(0); PG8_BAR; PG8_MMA(0, 0, At, B0); PG8_MMA(0, 1, At, B1); PG8_BAR; PG8_SCHED;
            PG8_LDA(At, 0, 1); PG8_STAGE(PG8_SB(0, 0), b2, voffB); PG8_STAGE(PG8_SB(0, 1), b2 + hstep, voffB); PG8_STAGE(PG8_SA(0, 0), a2, voffA);
            PG8_WAIT_V(8); PG8_WAIT_L(0); PG8_BAR; PG8_MMA(1, 0, At, B0); PG8_MMA(1, 1, At, B1); PG8_BAR; PG8_SCHED;
            PG8_LDB(B0, 1, 0); PG8_LDB(B1, 1, 1); PG8_SCHED; PG8_LDA(At, 1, 0); PG8_STAGE(PG8_SA(0, 1), a2 + hstep, voffA);
            PG8_WAIT_V(8); PG8_WAIT_L(0); PG8_BAR; PG8_MMA(0, 0, At, B0); PG8_MMA(0, 1, At, B1); PG8_BAR; PG8_SCHED;
            PG8_LDA(At, 1, 1); PG8_STAGE(PG8_SB(1, 0), b3, voffB); PG8_STAGE(PG8_SB(1, 1), b3 + hstep, voffB); PG8_STAGE(PG8_SA(1, 0), a3, voffA);
            PG8_WAIT_V(8); PG8_WAIT_L(0); PG8_BAR; PG8_MMA(1, 0, At, B0); PG8_MMA(1, 1, At, B1); PG8_BAR; PG8_SCHED;
            } else {
            PG8_LDB(B0, 0, 0); PG8_SCHED; PG8_LDA(At, 0, 0); PG8_STAGE(PG8_SA(1, 1), a1 + hstep, voffA);
            PG8_WAIT_L(8); PG8_BAR; PG8_WAIT_L(0); PG8_MMA(0, 0, At, B0); PG8_BAR; PG8_SCHED;
            PG8_LDB(B1, 0, 1); PG8_STAGE(PG8_SB(0, 0), b2, voffB);
            PG8_BAR; PG8_WAIT_L(0); PG8_MMA(0, 1, At, B1); PG8_BAR;
            PG8_LDA(At, 0, 1); PG8_STAGE(PG8_SA(0, 0), a2, voffA);
            PG8_BAR; PG8_WAIT_L(0); PG8_MMA(1, 0, At, B0); PG8_BAR; PG8_SCHED;
            PG8_STAGE(PG8_SB(0, 1), b2 + hstep, voffB);
            PG8_WAIT_V(6); PG8_BAR; PG8_MMA(1, 1, At, B1); PG8_BAR;
            PG8_LDB(B0, 1, 0); PG8_SCHED; PG8_LDA(At, 1, 0); PG8_STAGE(PG8_SA(0, 1), a2 + hstep, voffA);
            PG8_WAIT_L(8); PG8_BAR; PG8_WAIT_L(0); PG8_MMA(0, 0, At, B0); PG8_BAR; PG8_SCHED;
            PG8_LDB(B1, 1, 1); PG8_STAGE(PG8_SB(1, 0), b3, voffB);
            PG8_BAR; PG8_WAIT_L(0); PG8_MMA(0, 1, At, B1); PG8_BAR;
            PG8_LDA(At, 1, 1); PG8_STAGE(PG8_SA(1, 0), a3, voffA);
            PG8_BAR; PG8_WAIT_L(0); PG8_MMA(1, 0, At, B0); PG8_BAR; PG8_SCHED;
            PG8_STAGE(PG8_SB(1, 1), b3 + hstep, voffB);
            PG8_WAIT_V(6); PG8_BAR; PG8_MMA(1, 1, At, B1); PG8_BAR;
            }
        }
        if constexpr (ALIGN_EPI) { if (wr == 0) PG8_BAR; }
        if constexpr (!Epi::AFTER_DRAIN) { E(acc, cur, wr, wc, fr, fq); S.done(cur); }
        if (!has_next) break;
#pragma unroll
        for (int a = 0; a < 2; ++a)
#pragma unroll
            for (int b = 0; b < 2; ++b)
#pragma unroll
                for (int m = 0; m < 4; ++m)
#pragma unroll
                    for (int n = 0; n < 2; ++n) acc[a][b][m][n] = (f32x4){0.f, 0.f, 0.f, 0.f};
        cur = nxt; cA = nA; cB = nB; ++ui;
        if constexpr (ALIGN_EPI) { if (wr == 1) PG8_BAR; }
    }
    PG8_WAIT_V(0);
    if constexpr (!ALIGN_EPI) { if (wr == 0) PG8_BAR; }
    PG8_BAR;
    if constexpr (Epi::AFTER_DRAIN) { E.fused(acc, cur, wr, wc, fr, fq, lds, wid, lane); S.done(cur); }
#undef PG8_SA
#undef PG8_SB
#undef PG8_STAGE
#undef PG8_LDA
#undef PG8_LDB
#undef PG8_MMA
#undef PG8_WAIT_V
#undef PG8_WAIT_L
#undef PG8_BAR
#undef PG8_SCHED
}
}

typedef unsigned short bf16;
typedef short bf16x8 __attribute__((ext_vector_type(8)));
typedef float f32x4 __attribute__((ext_vector_type(4)));
typedef float f32x16 __attribute__((ext_vector_type(16)));
typedef unsigned u32x4 __attribute__((ext_vector_type(4)));
typedef unsigned u32x2 __attribute__((ext_vector_type(2)));
typedef float f32x2_t __attribute__((ext_vector_type(2)));
typedef __bf16 bf16x2_t __attribute__((ext_vector_type(2)));

constexpr int T_ = 16384, S_ = 4096, DM_ = 1024, DFF_ = 2816, NIN_ = 6656;
constexpr float LOG2E = 1.4426950408889634f;
constexpr float QC2 = 0.125f * LOG2E;
constexpr float RMS_EPS = 1e-6f;
constexpr size_t MiB = 1u << 20;
constexpr size_t WS_CTL = 0;
constexpr size_t WS_DEC = 1 * MiB;
constexpr size_t WS_KCB = 1 * MiB + 512 * 1024;
constexpr size_t WS_VCB = WS_KCB + 256 * 1024;
constexpr size_t WS_W1T = 2 * MiB;
constexpr size_t WS_PEW = 2 * MiB + 512 * 1024;
constexpr size_t WS_SS = 3 * MiB;
constexpr size_t WS_WIN = 4 * MiB;
constexpr size_t WS_WGU = 4 * MiB;
constexpr size_t WS_WPG = 17 * MiB, WS_WPN = 19 * MiB, WS_WOUT = 20 * MiB;
constexpr size_t WS_XN = 22 * MiB;
constexpr size_t WS_KD = 22 * MiB, WS_WD = 38 * MiB;
constexpr size_t WS_GQ = 54 * MiB, WS_GK = 70 * MiB, WS_GV = 86 * MiB, WS_GR = 118 * MiB, WS_NQ = 150 * MiB, WS_NKV = 166 * MiB;
constexpr size_t WS_MG = 190 * MiB, WS_MN = 222 * MiB, WS_GSM = 254 * MiB;
constexpr size_t WS_MIX = 86 * MiB, WS_Y = 54 * MiB, WS_XN2 = 118 * MiB, WS_HID = 150 * MiB, WS_F = 54 * MiB;
constexpr int LDS_BYTES = 147456;

__device__ __forceinline__ unsigned pk2(float lo, float hi) { f32x2_t v = {lo, hi}; bf16x2_t b = __builtin_convertvector(v, bf16x2_t); return __builtin_bit_cast(unsigned, b); }
__device__ __forceinline__ bf16 f2bf(float f) { return (bf16)(pk2(f, 0.f) & 0xffffu); }
__device__ __forceinline__ float bf2f(unsigned b) { return __uint_as_float(b << 16); }
__device__ __forceinline__ float bflo(unsigned w) { return __uint_as_float(w << 16); }
__device__ __forceinline__ float bfhi(unsigned w) { return __uint_as_float(w & 0xffff0000u); }
__device__ __forceinline__ float sigmoidf_(float x) { return 1.f / (1.f + __expf(-x)); }
__device__ __forceinline__ float siluf_(float x) { return x / (1.f + __expf(-x)); }
__device__ __forceinline__ float wave_sum(float v) {
#pragma unroll
    for (int o = 1; o < 64; o <<= 1) v += __shfl_xor(v, o);
    return v;
}
__device__ __forceinline__ int crow(int r, int hi) { return (r & 3) + 8 * (r >> 2) + 4 * hi; }
__device__ __forceinline__ bf16x8 mk8(u32x2 a, u32x2 b) { u32x4 v = {a.x, a.y, b.x, b.y}; return __builtin_bit_cast(bf16x8, v); }
#define MFMA32(a, b, c) __builtin_amdgcn_mfma_f32_32x32x16_bf16((a), (b), (c), 0, 0, 0)

using pg8::Unit;
struct EpiIn {
    static constexpr bool PERM = true, AFTER_DRAIN = false; static constexpr int MID_T = -1;
    unsigned char* ws;
    __device__ __forceinline__ void operator()(const pg8::f32x4 (&acc)[2][2][4][2], const Unit& u, int wr, int wc, int fr, int fq) const {
        const int pn = u.pn; size_t off; int ld, ct; float sc = 1.f;
        if (pn < 2) { off = WS_GQ; ld = 512; ct = pn; }
        else if (pn < 4) { off = WS_GK; ld = 512; ct = pn - 2; }
        else if (pn < 8) { off = WS_GV; ld = 1024; ct = pn - 4; }
        else if (pn < 12) { off = WS_GR; ld = 1536; ct = pn - 8; }
        else if (pn < 14) { off = WS_GR + 2048; ld = 1536; ct = pn - 12; sc = QC2; }
        else if (pn < 17) { off = WS_NKV; ld = 768; ct = pn - 14; }
        else if (pn < 21) { off = WS_MG; ld = 1024; ct = pn - 17; }
        else if (pn < 25) { off = WS_MN; ld = 1024; ct = pn - 21; }
        else { off = WS_GSM; ld = 64; ct = 0; }
        bf16* base = (bf16*)(ws + off);
        const int row0 = u.pm * 256 + wr * 64 + fr;
#pragma unroll
        for (int ai = 0; ai < 2; ++ai)
#pragma unroll
            for (int m = 0; m < 4; ++m) {
                const int row = row0 + ai * 128 + m * 16;
#pragma unroll
                for (int bj = 0; bj < 2; ++bj) {
                    if (pn == 25 && (bj != 0 || wc >= 2)) continue;
                    const int col = ct * 256 + bj * 128 + wc * 32 + 8 * fq;
                    const pg8::f32x4 v0 = acc[ai][bj][m][0] * sc, v1 = acc[ai][bj][m][1] * sc;
                    u32x4 w; w.x = pk2(v0[0], v0[1]); w.y = pk2(v0[2], v0[3]); w.z = pk2(v1[0], v1[1]); w.w = pk2(v1[2], v1[3]);
                    *(u32x4*)(base + (size_t)row * ld + col) = w;
                }
            }
    }
};
template <bool ADD> struct EpiMix {
    static constexpr bool PERM = true, AFTER_DRAIN = false; static constexpr int MID_T = -1;
    const bf16* gate; bf16* out;
    __device__ __forceinline__ void operator()(const pg8::f32x4 (&acc)[2][2][4][2], const Unit& u, int wr, int wc, int fr, int fq) const {
        const int row0 = u.pm * 256 + wr * 64 + fr;
#pragma unroll
        for (int ai = 0; ai < 2; ++ai)
#pragma unroll
            for (int m = 0; m < 4; ++m) {
                const int row = row0 + ai * 128 + m * 16;
#pragma unroll
                for (int bj = 0; bj < 2; ++bj) {
                    const int col = u.pn * 256 + bj * 128 + wc * 32 + 8 * fq;
                    const size_t o = (size_t)row * 1024 + col;
                    const u32x4 gw = *(const u32x4*)(gate + o);
                    const pg8::f32x4 a0 = acc[ai][bj][m][0], a1 = acc[ai][bj][m][1];
                    float v[8];
                    v[0] = sigmoidf_(bflo(gw.x)) * a0[0]; v[1] = sigmoidf_(bfhi(gw.x)) * a0[1];
                    v[2] = sigmoidf_(bflo(gw.y)) * a0[2]; v[3] = sigmoidf_(bfhi(gw.y)) * a0[3];
                    v[4] = sigmoidf_(bflo(gw.z)) * a1[0]; v[5] = sigmoidf_(bfhi(gw.z)) * a1[1];
                    v[6] = sigmoidf_(bflo(gw.w)) * a1[2]; v[7] = sigmoidf_(bfhi(gw.w)) * a1[3];
                    if (ADD) {
                        const u32x4 pw = *(const u32x4*)(out + o);
                        v[0] += bflo(pw.x); v[1] += bfhi(pw.x); v[2] += bflo(pw.y); v[3] += bfhi(pw.y);
                        v[4] += bflo(pw.z); v[5] += bfhi(pw.z); v[6] += bflo(pw.w); v[7] += bfhi(pw.w);
                    }
                    u32x4 w; w.x = pk2(v[0], v[1]); w.y = pk2(v[2], v[3]); w.z = pk2(v[4], v[5]); w.w = pk2(v[6], v[7]);
                    *(u32x4*)(out + o) = w;
                }
            }
    }
};
struct EpiMixC {
    static constexpr bool PERM = true, AFTER_DRAIN = false; static constexpr int MID_T = 16;
    const bf16* mg; const bf16* mn; bf16* out;
    __device__ __forceinline__ void mid(pg8::f32x4 (&acc)[2][2][4][2], const Unit& u, int wr, int wc, int fr, int fq) const {
        int row0 = u.pm * 256 + wr * 64 + fr; asm volatile("" : "+v"(row0));
        int fq8 = 8 * fq; asm volatile("" : "+v"(fq8));
#pragma unroll
        for (int ai = 0; ai < 2; ++ai) {
            u32x4 ga[4][2], gb[4][2];
#pragma unroll
            for (int m = 0; m < 4; ++m)
#pragma unroll
                for (int bj = 0; bj < 2; ++bj) {
                    const size_t o = (size_t)(row0 + ai * 128 + m * 16) * 1024 + u.pn * 256 + bj * 128 + wc * 32 + fq8;
                    ga[m][bj] = *(const u32x4*)(mg + o); gb[m][bj] = *(const u32x4*)(mn + o);
                }
#pragma unroll
            for (int m = 0; m < 4; ++m)
#pragma unroll
                for (int bj = 0; bj < 2; ++bj) {
                    const unsigned aw[4] = {ga[m][bj].x, ga[m][bj].y, ga[m][bj].z, ga[m][bj].w}, bw[4] = {gb[m][bj].x, gb[m][bj].y, gb[m][bj].z, gb[m][bj].w};
#pragma unroll
                    for (int e = 0; e < 4; ++e) {
                        const float r0 = (1.f + __expf(-bflo(bw[e]))) / (1.f + __expf(-bflo(aw[e])));
                        const float r1 = (1.f + __expf(-bfhi(bw[e]))) / (1.f + __expf(-bfhi(aw[e])));
                        acc[ai][bj][m][e >> 1][(e & 1) * 2 + 0] *= r0; acc[ai][bj][m][e >> 1][(e & 1) * 2 + 1] *= r1;
                    }
                }
            asm volatile("" ::: "memory");
        }
    }
    __device__ __forceinline__ void operator()(const pg8::f32x4 (&acc)[2][2][4][2], const Unit& u, int wr, int wc, int fr, int fq) const {
        const int row0 = u.pm * 256 + wr * 64 + fr;
#pragma unroll
        for (int ai = 0; ai < 2; ++ai)
#pragma unroll
            for (int m = 0; m < 4; ++m) {
                const int row = row0 + ai * 128 + m * 16;
#pragma unroll
                for (int bj = 0; bj < 2; ++bj) {
                    const size_t o = (size_t)row * 1024 + u.pn * 256 + bj * 128 + wc * 32 + 8 * fq;
                    const u32x4 gw = *(const u32x4*)(mn + o);
                    const pg8::f32x4 a0 = acc[ai][bj][m][0], a1 = acc[ai][bj][m][1];
                    u32x4 w;
                    w.x = pk2(sigmoidf_(bflo(gw.x)) * a0[0], sigmoidf_(bfhi(gw.x)) * a0[1]); w.y = pk2(sigmoidf_(bflo(gw.y)) * a0[2], sigmoidf_(bfhi(gw.y)) * a0[3]);
                    w.z = pk2(sigmoidf_(bflo(gw.z)) * a1[0], sigmoidf_(bfhi(gw.z)) * a1[1]); w.w = pk2(sigmoidf_(bflo(gw.w)) * a1[2], sigmoidf_(bfhi(gw.w)) * a1[3]);
                    *(u32x4*)(out + o) = w;
                }
            }
    }
};
struct EpiNorm {
    static constexpr bool PERM = true, AFTER_DRAIN = false; static constexpr int MID_T = -1;
    bf16* out; float* ss;
    __device__ __forceinline__ void operator()(const pg8::f32x4 (&acc)[2][2][4][2], const Unit& u, int wr, int wc, int fr, int fq) const {
        const int row0 = u.pm * 256 + wr * 64 + fr;
#pragma unroll
        for (int ai = 0; ai < 2; ++ai)
#pragma unroll
            for (int m = 0; m < 4; ++m) {
                const int row = row0 + ai * 128 + m * 16;
                float s = 0.f;
#pragma unroll
                for (int bj = 0; bj < 2; ++bj) {
                    const int col = u.pn * 256 + bj * 128 + wc * 32 + 8 * fq;
                    const pg8::f32x4 v0 = acc[ai][bj][m][0], v1 = acc[ai][bj][m][1];
                    s += v0[0] * v0[0] + v0[1] * v0[1] + v0[2] * v0[2] + v0[3] * v0[3] + v1[0] * v1[0] + v1[1] * v1[1] + v1[2] * v1[2] + v1[3] * v1[3];
                    u32x4 w; w.x = pk2(v0[0], v0[1]); w.y = pk2(v0[2], v0[3]); w.z = pk2(v1[0], v1[1]); w.w = pk2(v1[2], v1[3]);
                    *(u32x4*)(out + (size_t)row * 1024 + col) = w;
                }
                s += __shfl_xor(s, 16); s += __shfl_xor(s, 32);
                if (fq == 0) ss[(size_t)row * 16 + u.pn * 4 + wc] = s;
            }
    }
};
struct EpiGU {
    static constexpr bool PERM = true, AFTER_DRAIN = false; static constexpr int MID_T = -1;
    bf16* out;
    __device__ __forceinline__ void operator()(const pg8::f32x4 (&acc)[2][2][4][2], const Unit& u, int wr, int wc, int fr, int fq) const {
        const int row0 = u.pm * 256 + wr * 64 + fr;
#pragma unroll
        for (int ai = 0; ai < 2; ++ai)
#pragma unroll
            for (int m = 0; m < 4; ++m) {
                const int row = row0 + ai * 128 + m * 16;
#pragma unroll
                for (int bj = 0; bj < 2; ++bj) {
                    const int col = u.pn * 256 + bj * 128 + wc * 32 + 8 * fq;
                    const pg8::f32x4 v0 = acc[ai][bj][m][0], v1 = acc[ai][bj][m][1];
                    u32x2 w; w.x = pk2(siluf_(v0[0]) * v0[1], siluf_(v0[2]) * v0[3]); w.y = pk2(siluf_(v1[0]) * v1[1], siluf_(v1[2]) * v1[3]);
                    *(u32x2*)(out + (size_t)row * DFF_ + (col >> 1)) = w;
                }
            }
    }
};

constexpr size_t WS_XB = 52 * MiB + 512 * 1024;
constexpr int CW_CNT = 8192;
struct RmsPanel {
    unsigned* xbuf; unsigned* cnt;
    __device__ __forceinline__ void run(const pg8::f32x4 (&v)[2][2][4][2], const Unit& u, int wr, int wc, int fr, int fq, PG8_LAS unsigned char* lds, int wid, int lane) const {
        PG8_LAS float* P = (PG8_LAS float*)lds;
        PG8_LAS float* S = (PG8_LAS float*)(lds + 8192);
#pragma unroll
        for (int ai = 0; ai < 2; ++ai)
#pragma unroll
            for (int m = 0; m < 4; ++m) {
                float q = 0.f;
#pragma unroll
                for (int bj = 0; bj < 2; ++bj)
#pragma unroll
                    for (int n = 0; n < 2; ++n) { const pg8::f32x4 x = v[ai][bj][m][n]; q += (x[0] * x[0] + x[1] * x[1]) + (x[2] * x[2] + x[3] * x[3]); }
                q += __shfl_xor(q, 16); q += __shfl_xor(q, 32);
                if (fq == 0) P[(ai * 128 + wr * 64 + m * 16 + fr) * 4 + wc] = q;
            }
        asm volatile("s_waitcnt lgkmcnt(0)" ::: "memory"); __builtin_amdgcn_s_barrier(); asm volatile("" ::: "memory");
        const int row = wid * 32 + (lane & 31);
        if (lane < 32) {
            const float t = (P[row * 4 + 0] + P[row * 4 + 1]) + (P[row * 4 + 2] + P[row * 4 + 3]);
            __hip_atomic_store(xbuf + ((size_t)(u.pm * 256 + row) * 4 + u.pn), __float_as_uint(t), __ATOMIC_RELAXED, __HIP_MEMORY_SCOPE_AGENT);
        }
        asm volatile("s_waitcnt vmcnt(0)" ::: "memory");
        if (lane == 0) __hip_atomic_fetch_add(cnt + 64 * u.pm, 1u, __ATOMIC_RELAXED, __HIP_MEMORY_SCOPE_AGENT);
        if (wid == 0) {
            unsigned spins = 0;
            while ((unsigned)__builtin_amdgcn_readfirstlane(__hip_atomic_load(cnt + 64 * u.pm, __ATOMIC_RELAXED, __HIP_MEMORY_SCOPE_AGENT)) < 32u) { __builtin_amdgcn_s_sleep(2); if (++spins > (1u << 22)) break; }
            __builtin_amdgcn_fence(__ATOMIC_ACQUIRE, "agent");
        }
        asm volatile("s_waitcnt vmcnt(0) lgkmcnt(0)" ::: "memory"); __builtin_amdgcn_s_barrier(); asm volatile("" ::: "memory");
        if (lane < 32) {
            const unsigned* slot = xbuf + (size_t)(u.pm * 256 + row) * 4;
            float t = 0.f;
#pragma unroll
            for (int k = 0; k < 4; ++k) t += __uint_as_float(__hip_atomic_load(slot + k, __ATOMIC_RELAXED, __HIP_MEMORY_SCOPE_AGENT));
            S[row] = rsqrtf(t * (1.f / 1024.f) + RMS_EPS);
        }
        asm volatile("s_waitcnt vmcnt(0) lgkmcnt(0)" ::: "memory"); __builtin_amdgcn_s_barrier(); asm volatile("" ::: "memory");
    }
};
struct EpiRmsResRms {
    static constexpr bool PERM = false, AFTER_DRAIN = true; static constexpr int MID_T = -1;
    const float* x; float* out; bf16* xn; const float* g1; const float* g2; RmsPanel st1, st2;
    __device__ __forceinline__ void fused(pg8::f32x4 (&acc)[2][2][4][2], const Unit& u, int wr, int wc, int fr, int fq, PG8_LAS unsigned char* lds, int wid, int lane) const {
        const PG8_LAS float* S = (const PG8_LAS float*)(lds + 8192);
        const int col0 = u.pn * 256 + wc * 32 + 4 * fq;
        pg8::f32x4 pre[4][2][2];
#pragma unroll
        for (int m = 0; m < 4; ++m) { const size_t off = (size_t)(u.pm * 256 + wr * 64 + m * 16 + fr) * 1024 + col0;
#pragma unroll
            for (int bj = 0; bj < 2; ++bj)
#pragma unroll
                for (int n = 0; n < 2; ++n) pre[m][bj][n] = *(const pg8::f32x4*)(x + off + bj * 128 + n * 16); }
        pg8::f32x4 gv[2][2];
#pragma unroll
        for (int bj = 0; bj < 2; ++bj)
#pragma unroll
            for (int n = 0; n < 2; ++n) gv[bj][n] = *(const pg8::f32x4*)(g1 + col0 + bj * 128 + n * 16);
        st1.run(acc, u, wr, wc, fr, fq, lds, wid, lane);
        {
#pragma unroll
            for (int ai = 0; ai < 2; ++ai)
#pragma unroll
                for (int m = 0; m < 4; ++m) {
                    const int r = ai * 128 + wr * 64 + m * 16 + fr; const float sr = S[r]; const size_t off = (size_t)(u.pm * 256 + r) * 1024 + col0;
#pragma unroll
                    for (int bj = 0; bj < 2; ++bj)
#pragma unroll
                        for (int n = 0; n < 2; ++n) { const pg8::f32x4 xs = (ai == 0) ? pre[m][bj][n] : *(const pg8::f32x4*)(x + off + bj * 128 + n * 16); acc[ai][bj][m][n] = xs + acc[ai][bj][m][n] * sr * gv[bj][n]; }
                    asm volatile("" : "+v"(acc[ai][0][m][0]), "+v"(acc[ai][0][m][1]), "+v"(acc[ai][1][m][0]), "+v"(acc[ai][1][m][1]));
                    if (m & 1) asm volatile("" ::: "memory");
                }
        }
        pg8::f32x4 gw2[2][2];
#pragma unroll
        for (int bj = 0; bj < 2; ++bj)
#pragma unroll
            for (int n = 0; n < 2; ++n) gw2[bj][n] = *(const pg8::f32x4*)(g2 + col0 + bj * 128 + n * 16);
        st2.run(acc, u, wr, wc, fr, fq, lds, wid, lane);
        {
#pragma unroll
            for (int ai = 0; ai < 2; ++ai)
#pragma unroll
                for (int m = 0; m < 4; ++m) {
                    const int r = ai * 128 + wr * 64 + m * 16 + fr; const float sr = S[r]; const size_t off = (size_t)(u.pm * 256 + r) * 1024 + col0;
#pragma unroll
                    for (int bj = 0; bj < 2; ++bj)
#pragma unroll
                        for (int n = 0; n < 2; ++n) {
                            const pg8::f32x4 x1 = acc[ai][bj][m][n];
                            *(pg8::f32x4*)(out + off + bj * 128 + n * 16) = x1;
                            const pg8::f32x4 o = x1 * sr * gw2[bj][n];
                            u32x2 w; w.x = pk2(o[0], o[1]); w.y = pk2(o[2], o[3]);
                            *(u32x2*)(xn + off + bj * 128 + n * 16) = w;
                        }
                    asm volatile("" ::: "memory");
                }
        }
    }
};
struct EpiRmsRes {
    static constexpr bool PERM = false, AFTER_DRAIN = true; static constexpr int MID_T = -1;
    float* out; const float* g; RmsPanel st;
    __device__ __forceinline__ void fused(pg8::f32x4 (&acc)[2][2][4][2], const Unit& u, int wr, int wc, int fr, int fq, PG8_LAS unsigned char* lds, int wid, int lane) const {
        const PG8_LAS float* S = (const PG8_LAS float*)(lds + 8192);
        const int col0 = u.pn * 256 + wc * 32 + 4 * fq;
        pg8::f32x4 pre[4][2][2];
#pragma unroll
        for (int m = 0; m < 4; ++m) { const size_t off = (size_t)(u.pm * 256 + wr * 64 + m * 16 + fr) * 1024 + col0;
#pragma unroll
            for (int bj = 0; bj < 2; ++bj)
#pragma unroll
                for (int n = 0; n < 2; ++n) pre[m][bj][n] = *(const pg8::f32x4*)(out + off + bj * 128 + n * 16); }
        st.run(acc, u, wr, wc, fr, fq, lds, wid, lane);
        pg8::f32x4 gv[2][2];
#pragma unroll
        for (int bj = 0; bj < 2; ++bj)
#pragma unroll
            for (int n = 0; n < 2; ++n) gv[bj][n] = *(const pg8::f32x4*)(g + col0 + bj * 128 + n * 16);
#pragma unroll
        for (int ai = 0; ai < 2; ++ai)
#pragma unroll
            for (int m = 0; m < 4; ++m) {
                const int r = ai * 128 + wr * 64 + m * 16 + fr; const float sr = S[r]; const size_t off = (size_t)(u.pm * 256 + r) * 1024 + col0;
#pragma unroll
                for (int bj = 0; bj < 2; ++bj)
#pragma unroll
                    for (int n = 0; n < 2; ++n) { float* op = out + off + bj * 128 + n * 16; const pg8::f32x4 xs = (ai == 0) ? pre[m][bj][n] : *(const pg8::f32x4*)op; *(pg8::f32x4*)op = xs + acc[ai][bj][m][n] * sr * gv[bj][n]; }
                if (m == 3) asm volatile("" ::: "memory");
            }
    }
};

template <int MODE> __device__ __forceinline__ void tr_item(const float* W, int pitch, int K, int k0, int n0, bf16* WT, int drow0, float* scr, int lane) {
    float tv[32];
#pragma unroll
    for (int i = 0; i < 32; ++i) { const int kk = 2 * i + (lane >> 5); tv[i] = W[(size_t)(k0 + kk) * pitch + n0 + (lane & 31)]; }
#pragma unroll
    for (int i = 0; i < 32; ++i) { const int kk = 2 * i + (lane >> 5); scr[kk * 33 + (lane & 31)] = tv[i]; }
    __builtin_amdgcn_fence(__ATOMIC_RELEASE, "workgroup"); asm volatile("s_waitcnt lgkmcnt(0)" ::: "memory");
    const int c = lane & 7;
#pragma unroll
    for (int j = 0; j < 4; ++j) {
        const int n = (lane >> 3) + 8 * j; const float* s = scr + (8 * c) * 33 + n;
        u32x4 o; o.x = pk2(s[0 * 33], s[1 * 33]); o.y = pk2(s[2 * 33], s[3 * 33]); o.z = pk2(s[4 * 33], s[5 * 33]); o.w = pk2(s[6 * 33], s[7 * 33]);
        const int drow = (MODE == 0) ? (drow0 + n) : (2 * (n0 + n) + drow0);
        *(u32x4*)(WT + (size_t)drow * K + k0 + 8 * c) = o;
    }
    asm volatile("s_waitcnt lgkmcnt(0)" ::: "memory");
}
struct KP {
    const float* in[21]; float* out; unsigned char* ws; int ph_lo, ph_hi;
};
typedef const __attribute__((address_space(4))) KP* KPC;

__device__ __forceinline__ void phase0(KPC p, unsigned char* lds, int tid, int lane, int wave) {
    float* scr = (float*)(lds + wave * 16384);
    const int gw = blockIdx.x * 8 + wave, NGW = gridDim.x * 8;
    unsigned char* ws = p->ws;
    const int seg_src[8] = {0, 512, 1024, 2048, 3088, 3600, 4392, 5416};
    const int seg_w[8] = {512, 512, 1024, 1024, 512, 768, 1024, 1024};
    const int seg_dst[8] = {0, 512, 1024, 2048, 3072, 3584, 4352, 5376};
    constexpr int I_IN = 16 * 200, I_W1 = 32 * 2;
    constexpr int NIT = I_IN + 2 * I_W1;
    for (int it = gw; it < NIT; it += NGW) {
        int r = it;
        if (r < I_IN) {
            const int seg_start[9] = {0, 256, 512, 1024, 1536, 1792, 2176, 2688, 3200};
            int sgi = 0;
#pragma unroll
            for (int s = 1; s < 8; ++s) sgi += (r >= seg_start[s]) ? 1 : 0;
            int src = 0, wdt = 32, dst = 0, accum = 0;
#pragma unroll
            for (int s = 0; s < 8; ++s) if (s == sgi) { src = seg_src[s]; wdt = seg_w[s]; dst = seg_dst[s]; accum = seg_start[s]; }
            const int li = r - accum, nblk = wdt / 32, kb = li / nblk, nb = li % nblk;
            tr_item<0>(p->in[5], 6440, 1024, kb * 64, src + nb * 32, (bf16*)(ws + WS_WIN), dst + nb * 32, scr, lane);
            continue;
        }
        r -= I_IN;
        if (r < I_W1) { const int kb = r / 2, nb = r % 2; tr_item<0>(p->in[10], 64, 2048, kb * 64, nb * 32, (bf16*)(ws + WS_W1T), nb * 32, scr, lane); continue; }
        r -= I_W1;
        { const int kb = r / 2, nb = r % 2; tr_item<0>(p->in[13], 64, 2048, kb * 64, nb * 32, (bf16*)(ws + WS_W1T) + 64 * 2048, nb * 32, scr, lane); }
    }
    {
        bf16* WT = (bf16*)(ws + WS_WIN);
        for (int idx = blockIdx.x * 512 + tid; idx < 40 * 1024; idx += gridDim.x * 512) {
            const int k = idx / 40, c = idx - k * 40;
            const int col = c < 16 ? 3072 + c : 4368 + (c - 16);
            WT[(size_t)(6400 + c) * 1024 + k] = f2bf(p->in[5][(size_t)k * 6440 + col]);
        }
        u32x4* Z = (u32x4*)(WT + (size_t)6440 * 1024);
        for (int idx = blockIdx.x * 512 + tid; idx < 216 * 128; idx += gridDim.x * 512) Z[idx] = (u32x4){0u, 0u, 0u, 0u};
    }
    if ((int)blockIdx.x >= (int)gridDim.x - 64) {
        const int u = (int)gridDim.x - 1 - (int)blockIdx.x, kv = u & 1, part = u >> 1, c = tid & 63, kk = tid >> 6;
        const float* pe = kv ? p->in[12] : p->in[9]; const float* w1 = kv ? p->in[13] : p->in[10];
        float sacc = 0.f;
#pragma unroll
        for (int e = 0; e < 8; ++e) { const int k = part * 64 + kk * 8 + e; sacc += pe[k] * w1[(size_t)k * 64 + c]; }
        float* red = (float*)(lds + 8 * 16384);
        red[kk * 64 + c] = sacc;
        __syncthreads();
        if (tid < 64) { float t = 0.f;
#pragma unroll
            for (int q = 0; q < 8; ++q) t += red[q * 64 + tid];
            ((float*)(ws + WS_PEW))[(kv * 32 + part) * 64 + tid] = t; }
        __syncthreads();
    }
    {
        const float* g1 = p->in[1]; bf16* XN = (bf16*)(ws + WS_XN);
        for (int row = gw; row < T_; row += 2 * NGW) {
            const f32x4* xr0 = (const f32x4*)(p->in[0] + (size_t)row * 1024) + lane;
            const f32x4* xr1 = (const f32x4*)(p->in[0] + (size_t)(row + NGW) * 1024) + lane;
            f32x4 v0[4], v1[4]; float s0 = 0.f, s1 = 0.f;
#pragma unroll
            for (int j = 0; j < 4; ++j) { v0[j] = xr0[64 * j]; v1[j] = xr1[64 * j]; }
#pragma unroll
            for (int j = 0; j < 4; ++j) { s0 += v0[j][0] * v0[j][0] + v0[j][1] * v0[j][1] + v0[j][2] * v0[j][2] + v0[j][3] * v0[j][3]; s1 += v1[j][0] * v1[j][0] + v1[j][1] * v1[j][1] + v1[j][2] * v1[j][2] + v1[j][3] * v1[j][3]; }
            const float rstd0 = rsqrtf(wave_sum(s0) * (1.f / 1024.f) + RMS_EPS), rstd1 = rsqrtf(wave_sum(s1) * (1.f / 1024.f) + RMS_EPS);
            u32x2* o0 = (u32x2*)(XN + (size_t)row * 1024) + lane; u32x2* o1 = (u32x2*)(XN + (size_t)(row + NGW) * 1024) + lane;
#pragma unroll
            for (int j = 0; j < 4; ++j) {
                const f32x4 g = ((const f32x4*)g1)[lane + 64 * j];
                u32x2 w; w.x = pk2(v0[j][0] * rstd0 * g[0], v0[j][1] * rstd0 * g[1]); w.y = pk2(v0[j][2] * rstd0 * g[2], v0[j][3] * rstd0 * g[3]);
                o0[64 * j] = w;
                w.x = pk2(v1[j][0] * rstd1 * g[0], v1[j][1] * rstd1 * g[1]); w.y = pk2(v1[j][2] * rstd1 * g[2], v1[j][3] * rstd1 * g[3]);
                o1[64 * j] = w;
            }
        }
    }
}

__device__ __forceinline__ void compress_unit(KPC p, unsigned char* lds, int unit, int tid, int lane, int wave) {
    unsigned char* ws = p->ws;
    const int kvsel = unit >> 6, bg = (unit >> 3) & 7, rb = unit & 7, b = bg >> 1, g = bg & 1;
    const int r32 = lane & 31, hi = lane >> 5;
    const bf16* NKV = (const bf16*)(ws + WS_NKV);
    const bf16* W1T = (const bf16*)(ws + WS_W1T) + (size_t)kvsel * 64 * 2048;
    const int nrow = rb * 32 + r32, nld = nrow < 255 ? nrow : 254;
    f32x16 c0, c1;
#pragma unroll
    for (int r = 0; r < 16; ++r) { c0[r] = 0.f; c1[r] = 0.f; }
#pragma unroll
    for (int l4 = 0; l4 < 4; ++l4) {
        const int l = 4 * wave + l4;
        const size_t trow = (size_t)b * S_ + 16 * nld + l;
#pragma unroll
        for (int d0 = 0; d0 < 4; ++d0) {
            const bf16x8 a = *(const bf16x8*)(NKV + trow * 768 + kvsel * 128 + g * 64 + d0 * 16 + hi * 8);
            const int k = l * 64 + d0 * 16 + hi * 8;
            const bf16x8 b0 = *(const bf16x8*)(W1T + (size_t)r32 * 2048 + k);
            const bf16x8 b1 = *(const bf16x8*)(W1T + (size_t)(32 + r32) * 2048 + k);
            c0 = MFMA32(a, b0, c0); c1 = MFMA32(a, b1, c1);
        }
    }
    float* part = (float*)lds;
    float* H = (float*)(lds + 65536);
    float* W2s = (float*)(lds + 73728);
    { const float* w2g = kvsel ? p->in[14] : p->in[11];
#pragma unroll
      for (int e = 0; e < 8; ++e) W2s[tid + 512 * e] = w2g[tid + 512 * e]; }
#pragma unroll
    for (int r = 0; r < 16; ++r) { part[wave * 2048 + crow(r, hi) * 64 + r32] = c0[r]; part[wave * 2048 + crow(r, hi) * 64 + 32 + r32] = c1[r]; }
    __syncthreads();
    const float* PEW = (const float*)(ws + WS_PEW) + kvsel * 2048;
#pragma unroll
    for (int e = 0; e < 4; ++e) {
        const int idx = tid + 512 * e; float s = 0.f;
#pragma unroll 8
        for (int pi = 0; pi < 32; ++pi) s += PEW[pi * 64 + (idx & 63)];
#pragma unroll
        for (int w = 0; w < 8; ++w) s += part[w * 2048 + idx];
        H[idx] = siluf_(s);
    }
    __syncthreads();
    const float* w2 = kvsel ? p->in[14] : p->in[11];
    bf16* OUT = (bf16*)(ws + (kvsel ? WS_VCB : WS_KCB)) + (size_t)bg * 256 * 64;
#pragma unroll
    for (int e = 0; e < 4; ++e) {
        const int idx = tid + 512 * e, i = idx >> 6, c2 = idx & 63; float s = 0.f;
        for (int c = 0; c < 64; ++c) s += H[i * 64 + c] * W2s[c * 64 + c2];
        const int n = rb * 32 + i;
        if (kvsel == 0) OUT[(size_t)n * 64 + c2] = n < 255 ? f2bf(s) : (bf16)0;
        else OUT[(size_t)((n >> 6) * 64 + c2) * 64 + (n & 63)] = n < 255 ? f2bf(s) : (bf16)0;
    }
    __syncthreads();
}

__device__ __forceinline__ void gla_prep_unit(KPC p, unsigned char* lds, int unit, int tid, int lane, int wave) {
    unsigned char* ws = p->ws;
    const int n = unit & 63, b = unit >> 6;
    const size_t tr0 = (size_t)b * S_ + n * 64;
    const bf16* GSM = (const bf16*)(ws + WS_GSM);
    bf16* GQ = (bf16*)(ws + WS_GQ); bf16* GK = (bf16*)(ws + WS_GK); bf16* KD = (bf16*)(ws + WS_KD);
    {
        bf16* gv = (bf16*)(ws + WS_GV) + tr0 * 1024;
        u32x4 v0[8], v1[8];
#pragma unroll
        for (int e = 0; e < 8; ++e) { v0[e] = *(const u32x4*)(gv + (size_t)lane * 1024 + (2 * wave) * 64 + e * 8); v1[e] = *(const u32x4*)(gv + (size_t)lane * 1024 + (2 * wave + 1) * 64 + e * 8); }
        asm volatile("s_waitcnt vmcnt(0)" ::: "memory");
        __syncthreads();
        bf16* scr = (bf16*)(lds + wave * 8448); unsigned* s32 = (unsigned*)scr;
#pragma unroll
        for (int t = 0; t < 2; ++t) {
#pragma unroll
            for (int e = 0; e < 8; ++e) { const u32x4 v = t ? v1[e] : v0[e]; s32[lane * 33 + e * 4 + 0] = v.x; s32[lane * 33 + e * 4 + 1] = v.y; s32[lane * 33 + e * 4 + 2] = v.z; s32[lane * 33 + e * 4 + 3] = v.w; }
            __builtin_amdgcn_fence(__ATOMIC_RELEASE, "workgroup"); asm volatile("s_waitcnt lgkmcnt(0)" ::: "memory");
            bf16* dst = gv + (size_t)((2 * wave + t) * 64 + lane) * 64;
#pragma unroll
            for (int e = 0; e < 8; ++e) {
                unsigned w[4];
#pragma unroll
                for (int k = 0; k < 4; ++k) { const unsigned lo = scr[(e * 8 + 2 * k) * 66 + lane], hi = scr[(e * 8 + 2 * k + 1) * 66 + lane]; w[k] = lo | (hi << 16); }
                *(u32x4*)(dst + e * 8) = (u32x4){w[0], w[1], w[2], w[3]};
            }
            asm volatile("s_waitcnt lgkmcnt(0)" ::: "memory");
        }
    }
    __syncthreads();
    float* BT = (float*)lds;
    float* TOT = (float*)(lds + 32768);
    bf16* KDS = (bf16*)(lds + 36864);
    const int d = tid & 127, cgp = tid >> 7;
    for (int h = 0; h < 4; ++h) {
        const int bh = b * 4 + h;
        {
            float wa[16];
#pragma unroll
            for (int r = 0; r < 16; ++r) wa[r] = p->in[6][r * 512 + h * 128 + d];
            const float ba = p->in[7][h * 128 + d];
            float bc[16]; float run = 0.f;
#pragma unroll
            for (int i = 0; i < 16; ++i) {
                const int c = cgp * 16 + i;
                const u32x4 g0 = *(const u32x4*)(GSM + (tr0 + c) * 64), g1 = *(const u32x4*)(GSM + (tr0 + c) * 64 + 8);
                float x = ba;
                x += bflo(g0.x) * wa[0] + bfhi(g0.x) * wa[1] + bflo(g0.y) * wa[2] + bfhi(g0.y) * wa[3] + bflo(g0.z) * wa[4] + bfhi(g0.z) * wa[5] + bflo(g0.w) * wa[6] + bfhi(g0.w) * wa[7];
                x += bflo(g1.x) * wa[8] + bfhi(g1.x) * wa[9] + bflo(g1.y) * wa[10] + bfhi(g1.y) * wa[11] + bflo(g1.z) * wa[12] + bfhi(g1.z) * wa[13] + bflo(g1.w) * wa[14] + bfhi(g1.w) * wa[15];
                const float ls = fminf(x, 0.f) - __logf(1.f + __expf(-fabsf(x)));
                run += ls * (1.f / 16.f);
                bc[i] = run;
            }
            TOT[cgp * 128 + d] = run;
            __syncthreads();
            float prefix = 0.f;
#pragma unroll
            for (int q = 0; q < 3; ++q) if (q < cgp) prefix += TOT[q * 128 + d];
#pragma unroll
            for (int i = 0; i < 16; ++i) BT[(cgp * 16 + i) * 128 + d] = bc[i] + prefix;
            if (cgp == 0) ((float*)(ws + WS_DEC))[(size_t)(bh * 64 + n) * 128 + d] = __expf((TOT[d] + TOT[128 + d]) + (TOT[256 + d] + TOT[384 + d]));
        }
        __syncthreads();
        {
            const int c = tid >> 3, ds = (tid & 7) * 16;
            const size_t o = (tr0 + c) * 512 + h * 128 + ds;
            const u32x4 q0 = *(const u32x4*)(GQ + o), q1 = *(const u32x4*)(GQ + o + 8), k0 = *(const u32x4*)(GK + o), k1 = *(const u32x4*)(GK + o + 8);
            const unsigned qw[8] = {q0.x, q0.y, q0.z, q0.w, q1.x, q1.y, q1.z, q1.w}, kw[8] = {k0.x, k0.y, k0.z, k0.w, k1.x, k1.y, k1.z, k1.w};
            unsigned qo[8], ko[8];
            const float qs = 0.08838834764831845f;
#pragma unroll
            for (int e = 0; e < 8; ++e) {
                float r[2][3];
#pragma unroll
                for (int z = 0; z < 2; ++z) {
                    const int dd = ds + 2 * e + z;
                    const float bb = BT[c * 128 + dd];
                    const float tt = (TOT[dd] + TOT[128 + dd]) + (TOT[256 + dd] + TOT[384 + dd]);
                    const float q = z ? bfhi(qw[e]) : bflo(qw[e]), k = z ? bfhi(kw[e]) : bflo(kw[e]);
                    const float eb = __expf(bb), ie = __expf(-bb);
                    r[z][0] = q * qs * eb; r[z][1] = k * ie; r[z][2] = k * __expf(tt - bb);
                    KDS[dd * 72 + (c ^ (((dd >> 4) & 7) << 3))] = f2bf(r[z][2]);
                }
                qo[e] = pk2(r[0][0], r[1][0]); ko[e] = pk2(r[0][1], r[1][1]);
            }
            *(u32x4*)(GQ + o) = (u32x4){qo[0], qo[1], qo[2], qo[3]}; *(u32x4*)(GQ + o + 8) = (u32x4){qo[4], qo[5], qo[6], qo[7]};
            *(u32x4*)(GK + o) = (u32x4){ko[0], ko[1], ko[2], ko[3]}; *(u32x4*)(GK + o + 8) = (u32x4){ko[4], ko[5], ko[6], ko[7]};
        }
        __syncthreads();
        {
            const int dk = tid >> 2, part = tid & 3;
            const int ksw = (dk >> 4) & 7;
            const u32x4 a0 = *(const u32x4*)(KDS + dk * 72 + (((2 * part) ^ ksw) << 3)), a1 = *(const u32x4*)(KDS + dk * 72 + (((2 * part + 1) ^ ksw) << 3));
            bf16* kdt = KD + ((size_t)(bh * 64 + n) * 128 + dk) * 64 + part * 16;
            *(u32x4*)kdt = a0; *(u32x4*)(kdt + 8) = a1;
        }
        __syncthreads();
    }
}
__device__ __forceinline__ void tile_transpose64(bf16* base, bf16* scr, int lane) {
    u32x4 v[8];
#pragma unroll
    for (int e = 0; e < 8; ++e) v[e] = *(const u32x4*)(base + (size_t)lane * 768 + e * 8);
    unsigned* s32 = (unsigned*)scr;
#pragma unroll
    for (int e = 0; e < 8; ++e) { s32[lane * 33 + e * 4 + 0] = v[e].x; s32[lane * 33 + e * 4 + 1] = v[e].y; s32[lane * 33 + e * 4 + 2] = v[e].z; s32[lane * 33 + e * 4 + 3] = v[e].w; }
    __builtin_amdgcn_fence(__ATOMIC_RELEASE, "workgroup"); asm volatile("s_waitcnt lgkmcnt(0)" ::: "memory");
#pragma unroll
    for (int e = 0; e < 8; ++e) {
        unsigned w[4];
#pragma unroll
        for (int k = 0; k < 4; ++k) { const unsigned lo = scr[(e * 8 + 2 * k) * 66 + lane], hi = scr[(e * 8 + 2 * k + 1) * 66 + lane]; w[k] = lo | (hi << 16); }
        *(u32x4*)(base + (size_t)lane * 768 + e * 8) = (u32x4){w[0], w[1], w[2], w[3]};
    }
    asm volatile("s_waitcnt lgkmcnt(0)" ::: "memory");
}

__device__ __forceinline__ void phase2(KPC p, unsigned char* lds, int tid, int lane, int wave) {
    for (int u = (int)gridDim.x - 1 - (int)blockIdx.x; u < 128; u += gridDim.x) compress_unit(p, lds, u, tid, lane, wave);
    for (int u = blockIdx.x; u < 256; u += gridDim.x) gla_prep_unit(p, lds, u, tid, lane, wave);
    __syncthreads();
    {
        bf16* scrw = (bf16*)(lds + wave * 8448);
        const int gw0 = blockIdx.x * 8 + wave, NGW0 = gridDim.x * 8;
        for (int t = gw0; t < 1024; t += NGW0) {
            const int which = t & 1, g = (t >> 1) & 1, j = (t >> 2) & 63, b = t >> 8;
            tile_transpose64((bf16*)(p->ws + WS_NKV) + ((size_t)b * S_ + j * 64) * 768 + (which ? 640 : 384) + g * 64, scrw, lane);
        }
    }
    __syncthreads();
}

constexpr int GL_QE = 0, GL_KE = 17408, GL_KDT = 34816, GL_VT = 53248, GL_PS = 90112, GL_OST = 99328, GL_DEC = 133120;
constexpr size_t WS_SLOC = 44 * MiB, WS_DTOT = 52 * MiB;
constexpr int CTL_FLAG = 128;
__device__ __forceinline__ void gla_block(KPC p, unsigned char* lds, int bh, int seg, int tid, int lane, int wave, bool dostore = true, int fl = 0) {
    unsigned char* ws = p->ws;
    const int b = bh >> 2, h = bh & 3, r32 = lane & 31, hi = lane >> 5;
    bf16* QE = (bf16*)(lds + GL_QE); bf16* KE = (bf16*)(lds + GL_KE); bf16* KDT = (bf16*)(lds + GL_KDT); bf16* VT = (bf16*)(lds + GL_VT);
    bf16* PS = (bf16*)(lds + GL_PS); bf16* OST = (bf16*)(lds + GL_OST); float* DECS = (float*)(lds + GL_DEC);
    const bf16* gQ = (const bf16*)(ws + WS_GQ); const bf16* gK = (const bf16*)(ws + WS_GK); const bf16* gD = (const bf16*)(ws + WS_KD);
    const bf16* gV = (const bf16*)(ws + WS_GV); bf16* gR = (bf16*)(ws + WS_GR); const float* gDec = (const float*)(ws + WS_DEC);
    float* SLOC = (float*)(ws + WS_SLOC); float* DTOT = (float*)(ws + WS_DTOT);
    unsigned* FLAG = (unsigned*)(ws + WS_CTL) + CTL_FLAG + fl;
    const float* normg = p->in[8];
    const int lrow = tid >> 3, seg8 = tid & 7;
    const int n0 = seg * 16;
    f32x16 S[4];
#pragma unroll
    for (int i = 0; i < 4; ++i)
#pragma unroll
        for (int r = 0; r < 16; ++r) S[i][r] = 0.f;
    u32x4 rq[2], rk[2], rd[2], rv[4]; float rdec = 0.f;
#define GLA_PF_LIGHT(n_) do { \
        const bf16* kd_ = gD + ((size_t)(bh * 64 + (n_)) * 128 + (tid >> 2)) * 64 + (tid & 3) * 16; \
        rd[0] = *(const u32x4*)kd_; rd[1] = *(const u32x4*)(kd_ + 8); \
        const bf16* vt_ = gV + ((size_t)b * S_ + (n_) * 64) * 1024 + ((size_t)(h * 256 + (tid >> 1))) * 64 + (tid & 1) * 32; \
        rv[0] = *(const u32x4*)vt_; rv[1] = *(const u32x4*)(vt_ + 8); rv[2] = *(const u32x4*)(vt_ + 16); rv[3] = *(const u32x4*)(vt_ + 24); \
        if (tid < 128) rdec = gDec[(size_t)(bh * 64 + (n_)) * 128 + tid]; } while (0)
#define GLA_PF_QK(n_) do { const size_t o_ = ((size_t)b * S_ + (n_) * 64 + lrow) * 512 + h * 128 + seg8 * 16; \
        rq[0] = *(const u32x4*)(gQ + o_); rq[1] = *(const u32x4*)(gQ + o_ + 8); rk[0] = *(const u32x4*)(gK + o_); rk[1] = *(const u32x4*)(gK + o_ + 8); } while (0)
#define GLA_ST_LIGHT() do { \
        bf16* kl_ = KDT + (tid >> 2) * 72 + (tid & 3) * 16; *(u32x4*)kl_ = rd[0]; *(u32x4*)(kl_ + 8) = rd[1]; \
        bf16* vl_ = VT + (tid >> 1) * 72 + (tid & 1) * 32; *(u32x4*)vl_ = rv[0]; *(u32x4*)(vl_ + 8) = rv[1]; *(u32x4*)(vl_ + 16) = rv[2]; *(u32x4*)(vl_ + 24) = rv[3]; \
        if (tid < 128) DECS[tid] = rdec; } while (0)
#define GLA_ST_QK() do { \
        *(u32x4*)(QE + lrow * 136 + seg8 * 16) = rq[0]; *(u32x4*)(QE + lrow * 136 + seg8 * 16 + 8) = rq[1]; \
        *(u32x4*)(KE + lrow * 136 + seg8 * 16) = rk[0]; *(u32x4*)(KE + lrow * 136 + seg8 * 16 + 8) = rk[1]; } while (0)
#define GLA_SUPDATE() do { \
        _Pragma("unroll") for (int i = 0; i < 4; ++i) { \
            _Pragma("unroll") for (int q4 = 0; q4 < 4; ++q4) { const f32x4 dv = *(const f32x4*)(DECS + 32 * i + 8 * q4 + 4 * hi); \
                S[i][4 * q4 + 0] *= dv[0]; S[i][4 * q4 + 1] *= dv[1]; S[i][4 * q4 + 2] *= dv[2]; S[i][4 * q4 + 3] *= dv[3]; } } \
        _Pragma("unroll") for (int ks = 0; ks < 4; ++ks) { \
            _Pragma("unroll") for (int i = 0; i < 4; ++i) { const bf16x8 ka = *(const bf16x8*)(KDT + (32 * i + r32) * 72 + 16 * ks + 8 * hi); S[i] = MFMA32(ka, vb[ks], S[i]); } } } while (0)
    if (seg < 3) {
        float dprod = 1.f;
        GLA_PF_LIGHT(n0); GLA_ST_LIGHT();
        __syncthreads();
#pragma unroll 1
        for (int n = n0; n < n0 + 16; ++n) {
            if (n + 1 < n0 + 16) GLA_PF_LIGHT(n + 1);
            if (tid < 128) dprod *= DECS[tid];
            bf16x8 vb[4];
#pragma unroll
            for (int ks = 0; ks < 4; ++ks) vb[ks] = *(const bf16x8*)(VT + (32 * wave + r32) * 72 + 16 * ks + 8 * hi);
            GLA_SUPDATE();
            __syncthreads();
            if (n + 1 < n0 + 16) { GLA_ST_LIGHT(); }
            __syncthreads();
        }
        float* sl = SLOC + (size_t)(bh * 4 + seg) * 32768 + 32 * wave + r32;
#pragma unroll
        for (int i = 0; i < 4; ++i)
#pragma unroll
            for (int r = 0; r < 16; ++r) sl[(size_t)(32 * i + crow(r, hi)) * 256] = S[i][r];
        if (tid < 128) DTOT[(bh * 4 + seg) * 128 + tid] = dprod;
        asm volatile("s_waitcnt vmcnt(0)" ::: "memory");
        __syncthreads();
        if (tid == 0) {
            __builtin_amdgcn_fence(__ATOMIC_RELEASE, "agent");
            asm volatile("s_waitcnt vmcnt(0)" ::: "memory");
            __hip_atomic_store(FLAG + bh * 4 + seg, 1u, __ATOMIC_RELAXED, __HIP_MEMORY_SCOPE_AGENT);
        }
    }
#pragma unroll
    for (int i = 0; i < 4; ++i)
#pragma unroll
        for (int r = 0; r < 16; ++r) S[i][r] = 0.f;
    if (seg > 0) {
        if (tid == 0) {
            for (int s2 = 0; s2 < seg; ++s2) {
                unsigned spins = 0;
                while (__hip_atomic_load(FLAG + bh * 4 + s2, __ATOMIC_RELAXED, __HIP_MEMORY_SCOPE_AGENT) == 0u) { __builtin_amdgcn_s_sleep(4); if (++spins > (1u << 22)) break; }
            }
            __builtin_amdgcn_fence(__ATOMIC_ACQUIRE, "agent");
            asm volatile("s_waitcnt vmcnt(0)" ::: "memory");
        }
        __syncthreads();
#pragma unroll 1
        for (int s2 = 0; s2 < seg; ++s2) {
            const float* sl = SLOC + (size_t)(bh * 4 + s2) * 32768 + 32 * wave + r32;
            const float* dt = DTOT + (bh * 4 + s2) * 128;
#pragma unroll
            for (int i = 0; i < 4; ++i)
#pragma unroll
                for (int r = 0; r < 16; ++r) { const int dk = 32 * i + crow(r, hi);
                    const float dd = __hip_atomic_load(dt + dk, __ATOMIC_RELAXED, __HIP_MEMORY_SCOPE_AGENT), sv = __hip_atomic_load(sl + (size_t)dk * 256, __ATOMIC_RELAXED, __HIP_MEMORY_SCOPE_AGENT);
                    S[i][r] = dd * S[i][r] + sv; }
        }
    }
    GLA_PF_LIGHT(n0); GLA_PF_QK(n0);
    __syncthreads();
    GLA_ST_LIGHT(); GLA_ST_QK();
    __syncthreads();
#pragma unroll 1
    for (int n = n0; n < n0 + 16; ++n) {
        if (n + 1 < n0 + 16) { GLA_PF_LIGHT(n + 1); GLA_PF_QK(n + 1); }
        if (wave < 4) {
            const int ci = wave >> 1, si = wave & 1;
            f32x16 pc;
#pragma unroll
            for (int r = 0; r < 16; ++r) pc[r] = 0.f;
            if (si <= ci) {
#pragma unroll
                for (int kk = 0; kk < 8; ++kk) {
                    const bf16x8 a = *(const bf16x8*)(QE + (32 * ci + r32) * 136 + 16 * kk + 8 * hi);
                    const bf16x8 bb = *(const bf16x8*)(KE + (32 * si + r32) * 136 + 16 * kk + 8 * hi);
                    pc = MFMA32(a, bb, pc);
                }
            }
            const int s_idx = 32 * si + r32;
#pragma unroll
            for (int r = 0; r < 16; ++r) { const int c = 32 * ci + crow(r, hi); PS[c * 72 + s_idx] = f2bf(s_idx <= c ? pc[r] : 0.f); }
        }
        f32x16 o[2];
#pragma unroll
        for (int r = 0; r < 16; ++r) { o[0][r] = 0.f; o[1][r] = 0.f; }
#pragma unroll
        for (int i = 0; i < 4; ++i)
#pragma unroll
            for (int mm = 0; mm < 2; ++mm) {
                u32x4 sb; sb.x = pk2(S[i][8 * mm + 0], S[i][8 * mm + 1]); sb.y = pk2(S[i][8 * mm + 2], S[i][8 * mm + 3]); sb.z = pk2(S[i][8 * mm + 4], S[i][8 * mm + 5]); sb.w = pk2(S[i][8 * mm + 6], S[i][8 * mm + 7]);
                const bf16x8 bfr = __builtin_bit_cast(bf16x8, sb);
#pragma unroll
                for (int ch = 0; ch < 2; ++ch) {
                    const bf16* ap = QE + (32 * ch + r32) * 136 + 32 * i + 16 * mm + 4 * hi;
                    const bf16x8 a = mk8(*(const u32x2*)ap, *(const u32x2*)(ap + 8));
                    o[ch] = MFMA32(a, bfr, o[ch]);
                }
            }
        __syncthreads();
        bf16x8 vb[4];
#pragma unroll
        for (int ks = 0; ks < 4; ++ks) vb[ks] = *(const bf16x8*)(VT + (32 * wave + r32) * 72 + 16 * ks + 8 * hi);
#pragma unroll
        for (int ch = 0; ch < 2; ++ch)
#pragma unroll
            for (int ks = 0; ks < 4; ++ks) {
                const bf16x8 pa = *(const bf16x8*)(PS + (32 * ch + r32) * 72 + 16 * ks + 8 * hi);
                o[ch] = MFMA32(pa, vb[ks], o[ch]);
            }
        GLA_SUPDATE();
#pragma unroll
        for (int ch = 0; ch < 2; ++ch)
#pragma unroll
            for (int r = 0; r < 16; ++r) OST[(32 * ch + crow(r, hi)) * 264 + 32 * wave + r32] = f2bf(o[ch][r]);
        __syncthreads();
        if (n + 1 < n0 + 16) { GLA_ST_LIGHT(); GLA_ST_QK(); }
        {
            const bf16* op = OST + lrow * 264 + seg8 * 32;
            float ov[32];
#pragma unroll
            for (int e = 0; e < 4; ++e) {
                const u32x4 w = *(const u32x4*)(op + 8 * e);
                ov[8 * e + 0] = bflo(w.x); ov[8 * e + 1] = bfhi(w.x); ov[8 * e + 2] = bflo(w.y); ov[8 * e + 3] = bfhi(w.y);
                ov[8 * e + 4] = bflo(w.z); ov[8 * e + 5] = bfhi(w.z); ov[8 * e + 6] = bflo(w.w); ov[8 * e + 7] = bfhi(w.w);
            }
            float ss = 0.f;
#pragma unroll
            for (int e = 0; e < 32; ++e) ss += ov[e] * ov[e];
            ss += __shfl_xor(ss, 1); ss += __shfl_xor(ss, 2); ss += __shfl_xor(ss, 4);
            const float rstd = rsqrtf(ss * (1.f / 256.f) + RMS_EPS);
            bf16* rp = gR + ((size_t)b * S_ + n * 64 + lrow) * 1536 + h * 256 + seg8 * 32;
#pragma unroll
            for (int e = 0; e < 4; ++e) {
                const u32x4 rw = *(const u32x4*)(rp + 8 * e);
                const f32x4 g0 = *(const f32x4*)(normg + seg8 * 32 + 8 * e), g1 = *(const f32x4*)(normg + seg8 * 32 + 8 * e + 4);
                u32x4 w;
                w.x = pk2(ov[8 * e + 0] * rstd * g0[0] * siluf_(bflo(rw.x)), ov[8 * e + 1] * rstd * g0[1] * siluf_(bfhi(rw.x)));
                w.y = pk2(ov[8 * e + 2] * rstd * g0[2] * siluf_(bflo(rw.y)), ov[8 * e + 3] * rstd * g0[3] * siluf_(bfhi(rw.y)));
                w.z = pk2(ov[8 * e + 4] * rstd * g1[0] * siluf_(bflo(rw.z)), ov[8 * e + 5] * rstd * g1[1] * siluf_(bfhi(rw.z)));
                w.w = pk2(ov[8 * e + 6] * rstd * g1[2] * siluf_(bflo(rw.w)), ov[8 * e + 7] * rstd * g1[3] * siluf_(bfhi(rw.w)));
                if (dostore) *(u32x4*)(rp + 8 * e) = w;
            }
        }
        __syncthreads();
    }
#undef GLA_PF_LIGHT
#undef GLA_PF_QK
#undef GLA_ST_LIGHT
#undef GLA_ST_QK
#undef GLA_SUPDATE
}

constexpr int NS_KS = 0, NS_VT = 18432, NS_IMP = 36864, NS_SEL = 103424, NS_SCR = 103936, NS_NEED = 104960, NS_LIST = 105088, NS_UNIT = 105344;
struct NsaSt { float m, l; };
template <int KIND>
__device__ __forceinline__ int nsa_pass(unsigned char* lds, int ntiles, int tfirst, const bf16* Kb, const bf16* Vb, int pitch,
                                         const bf16x8 (&qr)[4], float sl2, int ql, int cur, int head, float& m, float& l, f32x16 (&o)[2],
                                         float mfix, float invl, int tid, int lane, int wave,
                                         bool pre, int b0, const bf16* nK, const bf16* nV, int npitch) {
    const int r32 = lane & 31, hi = lane >> 5;
    const int lrow = tid >> 3, ch = tid & 7;
    const int* tlist = (const int*)(lds + NS_LIST);
    float* scr = (float*)(lds + NS_SCR) + wave * 32;
    const unsigned long long selm = (KIND == 2) ? ((const unsigned long long*)(lds + NS_SEL))[ql] : 0ull;
    float* imp = (float*)(lds + NS_IMP) + ((size_t)head * 64 + ql) * 65;
    u32x4 kreg, vreg;
#define NS_TID(i_) ((KIND == 2) ? tlist[(i_)] : ((KIND == 3) ? (tfirst - (i_)) : (tfirst + (i_))))
#define NS_LOAD(i_) do { const int j_ = NS_TID(i_); const size_t ro_ = (size_t)(j_ * 64 + lrow) * pitch + ch * 8; kreg = *(const u32x4*)(Kb + ro_); vreg = *(const u32x4*)(Vb + ro_); } while (0)
#define NS_TW(base_, w_) do { const unsigned w__ = (w_); vt_[(base_) * 68 + lrow] = (bf16)(w__ & 0xffffu); vt_[((base_) + 1) * 68 + lrow] = (bf16)(w__ >> 16); } while (0)
#define NS_STORE(buf_) do { bf16* ks_ = (bf16*)(lds + NS_KS + (buf_) * 9216); bf16* vt_ = (bf16*)(lds + NS_VT + (buf_) * 9216); \
        *(u32x4*)(ks_ + lrow * 72 + ch * 8) = kreg; *(u32x4*)(vt_ + lrow * 72 + ch * 8) = vreg; } while (0)
    const float sstep = (KIND <= 1) ? 16.f * sl2 : sl2;
    f32x16 ci0, ci1;
#pragma unroll
    for (int r = 0; r < 16; ++r) { ci0[r] = sstep * (float)crow(r, hi); ci1[r] = ci0[r] + 32.f * sstep; }
    if (!pre) { NS_LOAD(0); NS_STORE(b0); __syncthreads(); }
    int buf = b0;
#pragma unroll 1
    for (int i = 0; i < ntiles; ++i) {
        const bool more = (i + 1 < ntiles);
        if (more) NS_LOAD(i + 1);
        else if (nK) { const size_t ro_ = (size_t)lrow * npitch + ch * 8; kreg = *(const u32x4*)(nK + ro_); vreg = *(const u32x4*)(nV + ro_); }
        const int j = NS_TID(i);
        const bf16* Ks = (const bf16*)(lds + NS_KS + buf * 9216); const bf16* VTs = (const bf16*)(lds + NS_VT + buf * 9216);
        f32x16 p0, p1;
#pragma unroll
        for (int d0 = 0; d0 < 4; ++d0) {
            const bf16x8 k0 = *(const bf16x8*)(Ks + r32 * 72 + d0 * 16 + hi * 8);
            const bf16x8 k1 = *(const bf16x8*)(Ks + (32 + r32) * 72 + d0 * 16 + hi * 8);
            if (d0 == 0) { p0 = MFMA32(k0, qr[0], ci0); p1 = MFMA32(k1, qr[0], ci1); }
            else { p0 = MFMA32(k0, qr[d0], p0); p1 = MFMA32(k1, qr[d0], p1); }
        }
        float cb; int limhi = 64, limlo = -1;
        if (KIND <= 1) { cb = sl2 * (float)(1024 * j + 31 - 64 * cur); limhi = ((64 * cur + ql - 31) >> 4) - 64 * j; }
        else {
            cb = sl2 * (float)(64 * (j - cur));
            if (KIND == 2) { if (!((selm >> j) & 1ull)) cb = -INFINITY; }
            if (j == cur) limhi = ql;
            if (KIND == 3 && j == cur - 8) limlo = ql;
        }
        if (__any(limhi < 63 || limlo >= 0)) {
#pragma unroll
            for (int r = 0; r < 16; ++r) { const int kv = crow(r, hi);
                if (kv > limhi || kv <= limlo) p0[r] = -INFINITY;
                if (kv + 32 > limhi || kv + 32 <= limlo) p1[r] = -INFINITY; }
        }
        float muse;
        if (KIND == 1) muse = mfix;
        else {
            float mx = fmaxf(p0[0], p1[0]);
#pragma unroll
            for (int r = 1; r < 16; ++r) mx = fmaxf(fmaxf(mx, p0[r]), p1[r]);
            mx += cb;
            mx = fmaxf(mx, __shfl_xor(mx, 32));
            const float mnew = (KIND >= 2 && !__any(mx > m + 8.f)) ? m : fmaxf(m, mx);
            muse = (mnew == -INFINITY) ? 0.f : mnew;
            const float alpha = __builtin_amdgcn_exp2f(m - muse);
            m = mnew;
            l *= alpha;
            if (KIND >= 2) {
                if (!__all(alpha == 1.f)) {
                    if (hi == 0) scr[r32] = alpha;
                    __builtin_amdgcn_fence(__ATOMIC_RELEASE, "workgroup"); asm volatile("s_waitcnt lgkmcnt(0)" ::: "memory");
#pragma unroll
                    for (int q4 = 0; q4 < 4; ++q4) {
                        const f32x4 av = *(const f32x4*)(scr + 8 * q4 + 4 * hi);
#pragma unroll
                        for (int e = 0; e < 4; ++e) { o[0][4 * q4 + e] *= av[e]; o[1][4 * q4 + e] *= av[e]; }
                    }
                    asm volatile("s_waitcnt lgkmcnt(0)" ::: "memory");
                }
            }
        }
        float ls = 0.f;
        const float base = cb - muse;
        if (KIND == 0) {
#pragma unroll
            for (int r = 0; r < 16; ++r) { p0[r] = __builtin_amdgcn_exp2f(p0[r] + base); p1[r] = __builtin_amdgcn_exp2f(p1[r] + base); ls += p0[r] + p1[r]; }
            l += ls;
        } else {
#pragma unroll
            for (int ks = 0; ks < 4; ++ks) {
                f32x16& P = (ks < 2) ? p0 : p1;
                const int rb = (ks & 1) * 8;
#pragma unroll
                for (int e = 0; e < 8; ++e) { float v = __builtin_amdgcn_exp2f(P[rb + e] + base); if (KIND == 1) v *= invl; P[rb + e] = v; ls += v; }
                u32x4 w; w.x = pk2(P[rb + 0], P[rb + 1]); w.y = pk2(P[rb + 2], P[rb + 3]); w.z = pk2(P[rb + 4], P[rb + 5]); w.w = pk2(P[rb + 6], P[rb + 7]);
                const bf16x8 pa = __builtin_bit_cast(bf16x8, w);
#pragma unroll
                for (int db = 0; db < 2; ++db) {
                    const bf16* vp = VTs + (db * 32 + r32) * 72 + 16 * ks + 4 * hi;
                    const bf16x8 vf = mk8(*(const u32x2*)vp, *(const u32x2*)(vp + 8));
                    o[db] = MFMA32(pa, vf, o[db]);
                }
            }
            if (KIND != 1) l += ls;
        }
        if (KIND == 1) {
#pragma unroll
            for (int a = 0; a < 4; ++a) {
                const int jb0 = 16 * j + 2 * a + hi, jb1 = jb0 + 8;
                imp[jb0] += p0[4 * a] + p0[4 * a + 1] + p0[4 * a + 2] + 0.5f * p0[4 * a + 3];
                imp[jb1] += p1[4 * a] + p1[4 * a + 1] + p1[4 * a + 2] + 0.5f * p1[4 * a + 3];
            }
            __builtin_amdgcn_fence(__ATOMIC_RELEASE, "workgroup"); asm volatile("s_waitcnt lgkmcnt(0)" ::: "memory");
#pragma unroll
            for (int a = 0; a < 4; ++a) {
                const int jb0 = 16 * j + 2 * a + hi, jb1 = jb0 + 8;
                imp[jb0 + 1] += 0.5f * p0[4 * a + 3];
                imp[jb1 + 1] += 0.5f * p1[4 * a + 3];
            }
            __builtin_amdgcn_fence(__ATOMIC_RELEASE, "workgroup"); asm volatile("s_waitcnt lgkmcnt(0)" ::: "memory");
        }
        if (more || nK) NS_STORE(buf ^ 1);
        __syncthreads();
        buf ^= 1;
    }
    return buf;
#undef NS_TID
#undef NS_LOAD
#undef NS_TW
#undef NS_STORE
}

__device__ __forceinline__ void nsa_unit(KPC p, unsigned char* lds, int unit, int tid_in, int lane_in, int wave, bool dostore = true) {
    int lane = lane_in; asm volatile("" : "+v"(lane));
    const int tid = wave * 64 + lane;
    unsigned char* ws = p->ws;
    const int bg = unit & 7, cur = 63 - (unit >> 3), b = bg >> 1, g = bg & 1;
    const int r32 = lane & 31, hi = lane >> 5, head = wave >> 1, ql = (wave & 1) * 32 + r32, hg = g * 4 + head;
    const size_t trow = (size_t)b * S_ + cur * 64 + ql;
    bf16* NQ = (bf16*)(ws + WS_GR) + 1024;
    const bf16* NKV = (const bf16*)(ws + WS_NKV) + (size_t)b * S_ * 768 + g * 64;
    const bf16* KCB = (const bf16*)(ws + WS_KCB) + (size_t)bg * 256 * 64; const bf16* VCB = (const bf16*)(ws + WS_VCB) + (size_t)bg * 256 * 64;
    const bf16* GSM = (const bf16*)(ws + WS_GSM);
    float* scr = (float*)(lds + NS_SCR) + wave * 32;
#define outp (NQ + ((size_t)b * S_ + cur * 64 + (wave & 1) * 32) * 1536 + hg * 64 + r32)
    bf16x8 qr[4];
#pragma unroll
    for (int d0 = 0; d0 < 4; ++d0) qr[d0] = *(const bf16x8*)(NQ + trow * 1536 + hg * 64 + d0 * 16 + hi * 8);
#define NS_GATE(k_) sigmoidf_(bf2f(GSM[((size_t)b * S_ + cur * 64 + ql) * 64 + 16 + hg * 3 + (k_)]))
    const float sl2 = exp2f(-(float)(hg + 1)) * LOG2E;
    { float* im = (float*)(lds + NS_IMP); for (int i = tid; i < 4 * 64 * 65; i += 512) im[i] = 0.f; }
    f32x16 o[2];
    float* accp = (float*)(lds + NS_IMP) + wave * 2048 + r32;
#define NS_FOLD(gk_, MODE_) do { \
        const float lt_ = l + __shfl_xor(l, 32); const float wq_ = lt_ > 0.f ? (gk_) / lt_ : 0.f; \
        if (hi == 0) scr[r32] = wq_; \
        __builtin_amdgcn_fence(__ATOMIC_RELEASE, "workgroup"); asm volatile("s_waitcnt lgkmcnt(0)" ::: "memory"); \
        _Pragma("unroll") for (int q4 = 0; q4 < 4; ++q4) { const f32x4 av = *(const f32x4*)(scr + 8 * q4 + 4 * hi); \
            _Pragma("unroll") for (int e = 0; e < 4; ++e) { const int r_ = 4 * q4 + e; const int ro_ = crow(r_, hi); \
                float a0_ = o[0][r_] * av[e], a1_ = o[1][r_] * av[e]; \
                if ((MODE_) >= 1) { a0_ += accp[ro_ * 64]; a1_ += accp[ro_ * 64 + 32]; } \
                if ((MODE_) <= 1) { accp[ro_ * 64] = a0_; accp[ro_ * 64 + 32] = a1_; } \
                else if (dostore) { outp[(size_t)ro_ * 1536] = f2bf(a0_); outp[(size_t)ro_ * 1536 + 32] = f2bf(a1_); } } } \
        asm volatile("s_waitcnt lgkmcnt(0)" ::: "memory"); } while (0)
#define NS_ZERO_O() do { _Pragma("unroll") for (int r = 0; r < 16; ++r) { o[0][r] = 0.f; o[1][r] = 0.f; } } while (0)
    float m, l;
    m = -INFINITY; l = 0.f; NS_ZERO_O();
    const int ncmp = ((4 * cur + 2) >> 6) + 1;
    int nb = nsa_pass<0>(lds, ncmp, 0, KCB, VCB, 64, qr, sl2, ql, cur, head, m, l, o, 0.f, 0.f, tid, lane, wave, false, 0, KCB, VCB, 64);
    {
        const float lt = l + __shfl_xor(l, 32);
        const float invl = lt > 0.f ? 1.f / lt : 0.f, mfix = (m == -INFINITY) ? 0.f : m;
        float m2 = m, l2 = 0.f;
        nb = nsa_pass<1>(lds, ncmp, 0, KCB, VCB, 64, qr, sl2, ql, cur, head, m2, l2, o, mfix, invl, tid, lane, wave, true, nb, NKV + 256 + (size_t)cur * 64 * 768, NKV + 384 + (size_t)cur * 64 * 768, 768);
    }
    {
        const float* im = (const float*)(lds + NS_IMP);
        unsigned long long* selp = (unsigned long long*)(lds + NS_SEL);
        unsigned long long uni = 0ull;
        const int jj = lane;
        const int nforced = cur == 0 ? 1 : (cur == 1 ? 2 : 3);
#pragma unroll 1
        for (int qi = 0; qi < 8; ++qi) {
            const int q = wave * 8 + qi;
            const float v = ((im[(0 * 64 + q) * 65 + jj] + im[(1 * 64 + q) * 65 + jj]) + im[(2 * 64 + q) * 65 + jj]) + im[(3 * 64 + q) * 65 + jj];
            const bool forced = (jj == 0) || (jj == cur) || (jj == cur - 1);
            const bool cand = (jj <= cur) && !forced;
            bool sel;
            if (cur + 1 <= 16) sel = (jj <= cur);
            else {
                const int K = 16 - nforced;
                const unsigned vb = __float_as_uint(v);
                unsigned T = 0u;
#pragma unroll 1
                for (int bit = 30; bit >= 0; --bit) {
                    const unsigned T2 = T | (1u << bit);
                    if (__popcll(__ballot(cand && vb >= T2)) >= K) T = T2;
                }
                const unsigned long long gt = __ballot(cand && vb > T), eq = __ballot(cand && vb == T);
                const int need = K - __popcll(gt);
                const int before = __popcll(eq & ((1ull << jj) - 1ull));
                sel = forced || (cand && (vb > T || (vb == T && before < need)));
            }
            const unsigned long long mk = __ballot(sel);
            if (lane == 0) selp[q] = mk;
            uni |= mk;
        }
        if (lane == 0) ((unsigned long long*)(lds + NS_NEED))[wave] = uni;
    }
    __syncthreads();
    int nsl = 0;
    {
        const unsigned long long* nd = (const unsigned long long*)(lds + NS_NEED);
        unsigned long long uni = 0ull;
#pragma unroll
        for (int w = 0; w < 8; ++w) uni |= nd[w];
        nsl = __popcll(uni);
        if (wave == 0) { int* tl = (int*)(lds + NS_LIST); const unsigned long long rest = uni & ~(1ull << cur);
            if (lane == 0) tl[0] = cur;
            if ((rest >> lane) & 1ull) tl[1 + __popcll(lane == 63 ? 0ull : (rest >> (lane + 1)))] = lane; }
    }
    __syncthreads();
    l = 0.5f; NS_FOLD(NS_GATE(0), 0);
    m = -INFINITY; l = 0.f; NS_ZERO_O();
    const int jfw = cur;
    nb = nsa_pass<2>(lds, nsl, 0, NKV + 256, NKV + 384, 768, qr, sl2, ql, cur, head, m, l, o, 0.f, 0.f, tid, lane, wave, true, nb, NKV + 512 + (size_t)jfw * 64 * 768, NKV + 640 + (size_t)jfw * 64 * 768, 768);
    NS_FOLD(NS_GATE(1), 1);
    m = -INFINITY; l = 0.f; NS_ZERO_O();
    {
        const int jf = cur - 8 < 0 ? 0 : cur - 8;
        nsa_pass<3>(lds, cur - jf + 1, cur, NKV + 512, NKV + 640, 768, qr, sl2, ql, cur, head, m, l, o, 0.f, 0.f, tid, lane, wave, true, nb, (const bf16*)nullptr, (const bf16*)nullptr, 0);
    }
    NS_FOLD(NS_GATE(2), 2);
    __syncthreads();
#undef NS_FOLD
#undef outp
#undef NS_GATE
#undef NS_ZERO_O
}

constexpr int LW_G = 16 * 88, LW_D = 44 * 32, LW_PG = 16 * 32, LW_PN = 8 * 32, LW_OUT = 16 * 32, LW_TOTAL = 2 * LW_G + LW_D + LW_PG + LW_PN + LW_OUT, LW_BLOCK_ITEMS = (LW_TOTAL + 7) / 8;
__device__ __forceinline__ void late_weight_item(KPC p, unsigned char* lds, int wi, int lane_in, int wave) {
    if (wi >= LW_TOTAL) return;
    int lane = lane_in; asm volatile("" : "+v"(lane));
    float* scr = (float*)(lds + wave * 16384);
    int r = wi;
    if (r < LW_G) { const int kb = r / 88, nb = r % 88; tr_item<1>(p->in[18], DFF_, 1024, kb * 64, nb * 32, (bf16*)(p->ws + WS_WGU), 0, scr, lane); return; }
    r -= LW_G;
    if (r < LW_G) { const int kb = r / 88, nb = r % 88; tr_item<1>(p->in[19], DFF_, 1024, kb * 64, nb * 32, (bf16*)(p->ws + WS_WGU), 1, scr, lane); return; }
    r -= LW_G;
    if (r < LW_D) { const int kb = r / 32, nb = r % 32; tr_item<0>(p->in[20], 1024, DFF_, kb * 64, nb * 32, (bf16*)(p->ws + WS_WD), nb * 32, scr, lane); return; }
    r -= LW_D;
    if (r < LW_PG) { const int kb = r / 32, nb = r % 32; tr_item<0>(p->in[15], 1024, 1536, kb * 64, nb * 32, (bf16*)(p->ws + WS_WPG), nb * 32, scr, lane); return; }
    r -= LW_PG;
    if (r < LW_PN) { const int kb = r / 32, nb = r % 32; tr_item<0>(p->in[16], 1024, 1536, kb * 64, nb * 32, (bf16*)(p->ws + WS_WPG) + 1024, nb * 32, scr, lane); return; }
    r -= LW_PN;
    { const int kb = r / 32, nb = r % 32; tr_item<0>(p->in[17], 1024, 1024, kb * 64, nb * 32, (bf16*)(p->ws + WS_WOUT), nb * 32, scr, lane); }
}

__device__ __forceinline__ void phase3(KPC p, unsigned char* lds, int tid, int lane, int wave) {
    const int NGLA = 16;
#if !(DIS & 1024)
    if ((int)blockIdx.x < 64) { if (DBL & 1024) gla_block(p, lds, blockIdx.x >> 2, blockIdx.x & 3, tid, lane, wave, false, 64); gla_block(p, lds, blockIdx.x >> 2, blockIdx.x & 3, tid, lane, wave); }
#endif
    unsigned* ctr = (unsigned*)(p->ws + WS_CTL);
    int* up = (int*)(lds + NS_UNIT);
    for (;;) {
        __syncthreads();
        if (tid == 0) *up = (int)atomicAdd(ctr, 1u);
        __syncthreads();
        const int u = *up;
        if (u >= 512 + LW_BLOCK_ITEMS) break;
        if (u >= 512) { late_weight_item(p, lds, (u - 512) * 8 + wave, lane, wave); continue; }
#if !(DIS & 2048)
        if (DBL & 2048) nsa_unit(p, lds, u, tid, lane, wave, false);
        nsa_unit(p, lds, u, tid, lane, wave);
#endif
    }
}

__device__ __forceinline__ void rowpass_a(KPC p, int lane, int wave) {
    const int gw = blockIdx.x * 8 + wave, NGW = gridDim.x * 8;
    const bf16* Y = (const bf16*)(p->ws + WS_Y); const float* SS = (const float*)(p->ws + WS_SS); bf16* XN2 = (bf16*)(p->ws + WS_XN2);
    const float* gpost = p->in[2]; const float* gpre2 = p->in[3];
    for (int row = gw; row < T_; row += NGW) {
        float s = lane < 16 ? SS[(size_t)row * 16 + lane] : 0.f;
        const float rstd = rsqrtf(wave_sum(s) * (1.f / 1024.f) + RMS_EPS);
        const u32x4 y0 = *(const u32x4*)(Y + (size_t)row * 1024 + lane * 16), y1 = *(const u32x4*)(Y + (size_t)row * 1024 + lane * 16 + 8);
        float yv[16] = {bflo(y0.x), bfhi(y0.x), bflo(y0.y), bfhi(y0.y), bflo(y0.z), bfhi(y0.z), bflo(y0.w), bfhi(y0.w),
                        bflo(y1.x), bfhi(y1.x), bflo(y1.y), bfhi(y1.y), bflo(y1.z), bfhi(y1.z), bflo(y1.w), bfhi(y1.w)};
        float x1[16]; float s2 = 0.f;
#pragma unroll
        for (int e = 0; e < 4; ++e) {
            const f32x4 xv = *(const f32x4*)(p->in[0] + (size_t)row * 1024 + lane * 16 + 4 * e);
            const f32x4 gv = *(const f32x4*)(gpost + lane * 16 + 4 * e);
            f32x4 r;
#pragma unroll
            for (int c = 0; c < 4; ++c) { r[c] = xv[c] + yv[4 * e + c] * rstd * gv[c]; x1[4 * e + c] = r[c]; s2 += r[c] * r[c]; }
            *(f32x4*)(p->out + (size_t)row * 1024 + lane * 16 + 4 * e) = r;
        }
        const float rstd2 = rsqrtf(wave_sum(s2) * (1.f / 1024.f) + RMS_EPS);
        u32x4 w0, w1;
        const f32x4 ga = *(const f32x4*)(gpre2 + lane * 16), gb = *(const f32x4*)(gpre2 + lane * 16 + 4), gc = *(const f32x4*)(gpre2 + lane * 16 + 8), gd = *(const f32x4*)(gpre2 + lane * 16 + 12);
        w0.x = pk2(x1[0] * rstd2 * ga[0], x1[1] * rstd2 * ga[1]); w0.y = pk2(x1[2] * rstd2 * ga[2], x1[3] * rstd2 * ga[3]);
        w0.z = pk2(x1[4] * rstd2 * gb[0], x1[5] * rstd2 * gb[1]); w0.w = pk2(x1[6] * rstd2 * gb[2], x1[7] * rstd2 * gb[3]);
        w1.x = pk2(x1[8] * rstd2 * gc[0], x1[9] * rstd2 * gc[1]); w1.y = pk2(x1[10] * rstd2 * gc[2], x1[11] * rstd2 * gc[3]);
        w1.z = pk2(x1[12] * rstd2 * gd[0], x1[13] * rstd2 * gd[1]); w1.w = pk2(x1[14] * rstd2 * gd[2], x1[15] * rstd2 * gd[3]);
        *(u32x4*)(XN2 + (size_t)row * 1024 + lane * 16) = w0; *(u32x4*)(XN2 + (size_t)row * 1024 + lane * 16 + 8) = w1;
    }
}
__device__ __forceinline__ void rowpass_b(KPC p, int lane, int wave) {
    const int gw = blockIdx.x * 8 + wave, NGW = gridDim.x * 8;
    const bf16* F = (const bf16*)(p->ws + WS_F); const float* SS = (const float*)(p->ws + WS_SS);
    const float* gpost = p->in[4];
    for (int row = gw; row < T_; row += NGW) {
        float s = lane < 16 ? SS[(size_t)row * 16 + lane] : 0.f;
        const float rstd = rsqrtf(wave_sum(s) * (1.f / 1024.f) + RMS_EPS);
        const u32x4 y0 = *(const u32x4*)(F + (size_t)row * 1024 + lane * 16), y1 = *(const u32x4*)(F + (size_t)row * 1024 + lane * 16 + 8);
        float yv[16] = {bflo(y0.x), bfhi(y0.x), bflo(y0.y), bfhi(y0.y), bflo(y0.z), bfhi(y0.z), bflo(y0.w), bfhi(y0.w),
                        bflo(y1.x), bfhi(y1.x), bflo(y1.y), bfhi(y1.y), bflo(y1.z), bfhi(y1.z), bflo(y1.w), bfhi(y1.w)};
#pragma unroll
        for (int e = 0; e < 4; ++e) {
            float* op = p->out + (size_t)row * 1024 + lane * 16 + 4 * e;
            const f32x4 xv = *(const f32x4*)op;
            const f32x4 gv = *(const f32x4*)(gpost + lane * 16 + 4 * e);
            f32x4 r;
#pragma unroll
            for (int c = 0; c < 4; ++c) r[c] = xv[c] + yv[4 * e + c] * rstd * gv[c];
            *(f32x4*)op = r;
        }
    }
}

#define XB_TMO      128
#define XB_XCNT(j)  (256  + 64 * (j))
#define XB_XSUB(j)  (1280 + 64 * (j))
#define XB_XGEN(j)  (2304 + 64 * (j))
#define XB_TOP      3328
#define XB_TOPGEN   3392
#define XCD_BAR_WORDS 3456
#define XB_SPIN_CAP (1u << 18)

__device__ __forceinline__ unsigned xb_ld(unsigned* p)              { return __hip_atomic_load(p, __ATOMIC_RELAXED, __HIP_MEMORY_SCOPE_AGENT); }
__device__ __forceinline__ unsigned xb_add(unsigned* p, unsigned v) { return __hip_atomic_fetch_add(p, v, __ATOMIC_RELAXED, __HIP_MEMORY_SCOPE_AGENT); }
__device__ __forceinline__ unsigned xb_xcc_id() { return (unsigned)__builtin_amdgcn_s_getreg((3 << 11) | 20) & 0xFu; }
#define XB_SPIN(cond, bar) do { unsigned _sp = 0; while (cond) { __builtin_amdgcn_s_sleep(1); \
    if ((++_sp & 255u) == 0u) { if (xb_ld(&(bar)[XB_TMO])) break; if (_sp > XB_SPIN_CAP) { atomicAdd(&(bar)[XB_TMO], 1u); break; } } } } while (0)

struct XcdBarrier {
    unsigned* bar; unsigned x;
    volatile PG8_LAS unsigned* st;
};

__device__ __forceinline__ XcdBarrier xcd_barrier_post(unsigned* bar, volatile PG8_LAS unsigned* st, bool leader) {
    XcdBarrier b; b.bar = bar; b.x = xb_xcc_id(); b.st = st;
    if (leader) (void)xb_add(&bar[XB_XCNT(b.x)], 1u);
    return b;
}
__device__ __forceinline__ void xcd_barrier_complete(unsigned* bar, unsigned x, unsigned& nloc, unsigned& nx) {
    const unsigned G = gridDim.x * gridDim.y * gridDim.z;
    unsigned sum, cnt, mine, sp = 0u;
    for (;;) {
        sum = 0u; cnt = 0u; mine = 0u;
#pragma unroll
        for (unsigned j = 0; j < 16; ++j) { const unsigned c = xb_ld(&bar[XB_XCNT(j)]); sum += c; cnt += (c > 0u) ? 1u : 0u; mine = (j == x) ? c : mine; }
        if (sum == G) break;
        __builtin_amdgcn_s_sleep(1);
        if ((++sp & 255u) == 0u) { if (xb_ld(&bar[XB_TMO])) break; if (sp > XB_SPIN_CAP) { atomicAdd(&bar[XB_TMO], 1u); break; } }
    }
    nloc = mine > 0u ? mine : 1u; nx = cnt > 0u ? cnt : 1u;
}

__device__ __forceinline__ void xcd_barrier(const XcdBarrier& b, bool leader) {
    asm volatile("s_waitcnt vmcnt(0)" ::: "memory");
    __syncthreads();
    if (leader) {
        unsigned* bar = b.bar;
        __builtin_amdgcn_s_waitcnt(0);
        unsigned nloc = b.st[0], nx = b.st[1];
        if (nloc == 0u) { xcd_barrier_complete(bar, b.x, nloc, nx); b.st[0] = nloc; b.st[1] = nx; }
        const unsigned old = xb_add(&bar[XB_XSUB(b.x)], 1u);
        const unsigned gen = old / nloc;
        if (old + 1u == (gen + 1u) * nloc) {
            __builtin_amdgcn_fence(__ATOMIC_RELEASE, "agent");
            asm volatile("s_waitcnt vmcnt(0)" ::: "memory");
            const unsigned og = xb_add(&bar[XB_TOP], 1u);
            const unsigned tg = og / nx;
            if (og + 1u == (tg + 1u) * nx) xb_add(&bar[XB_TOPGEN], 1u);
            else XB_SPIN(xb_ld(&bar[XB_TOPGEN]) == tg, bar);
            __builtin_amdgcn_fence(__ATOMIC_ACQUIRE, "agent");
            xb_add(&bar[XB_XGEN(b.x)], 1u);
            asm volatile("s_waitcnt vmcnt(0)" ::: "memory");
        } else {
            XB_SPIN(xb_ld(&bar[XB_XGEN(b.x)]) == gen, bar);
            __builtin_amdgcn_fence(__ATOMIC_ACQUIRE, "agent");
            asm volatile("s_waitcnt vmcnt(0)" ::: "memory");
        }
    }
    __syncthreads();
}

__device__ __forceinline__ void grid_bar(unsigned* bar, int wave, unsigned target) {
    asm volatile("s_waitcnt vmcnt(0) lgkmcnt(0)" ::: "memory");
    __syncthreads();
    if (wave == 0) {
        if ((int)__builtin_amdgcn_mbcnt_hi(~0u, __builtin_amdgcn_mbcnt_lo(~0u, 0u)) == 0) {
            __builtin_amdgcn_fence(__ATOMIC_RELEASE, "agent");
            asm volatile("s_waitcnt vmcnt(0)" ::: "memory");
            __hip_atomic_fetch_add(bar, 1u, __ATOMIC_RELAXED, __HIP_MEMORY_SCOPE_AGENT);
            unsigned spins = 0;
            while (__hip_atomic_load(bar, __ATOMIC_RELAXED, __HIP_MEMORY_SCOPE_AGENT) < target) { __builtin_amdgcn_s_sleep(2); if (++spins > (1u << 24)) break; }
            __builtin_amdgcn_fence(__ATOMIC_ACQUIRE, "agent");
            asm volatile("s_waitcnt vmcnt(0)" ::: "memory");
        }
    }
    __syncthreads();
}

constexpr int NPHASE = 10;
#ifndef LBN
#define LBN 2
#endif
__global__ void __launch_bounds__(512, LBN) fwd_kernel(KP pv) {
    KPC p = (KPC)__builtin_amdgcn_kernarg_segment_ptr();
    extern __shared__ __attribute__((aligned(16))) unsigned char lds[];
    const int wave = __builtin_amdgcn_readfirstlane(threadIdx.x >> 6);
#define lane ((int)__builtin_amdgcn_mbcnt_hi(~0u, __builtin_amdgcn_mbcnt_lo(~0u, 0u)))
#define tid (wave * 64 + lane)
    PG8_LAS unsigned char* ldsl = (PG8_LAS unsigned char*)lds;
    unsigned char* ws = p->ws;
    volatile PG8_LAS unsigned* xst = (volatile PG8_LAS unsigned*)(ldsl + 147440);
    if (wave == 0 && lane == 0) { xst[0] = 0u; xst[1] = 0u; }
    __syncthreads();
    const bool multi = (p->ph_hi - p->ph_lo) > 1;
    XcdBarrier xbar; xbar.bar = (unsigned*)(ws + WS_CTL) + 4096; xbar.x = 0; xbar.st = xst;
    if (multi) xbar = xcd_barrier_post((unsigned*)(ws + WS_CTL) + 4096, xst, wave == 0 && lane == 0);
    const int lo = p->ph_lo, hi = p->ph_hi;
    const bool fuse = multi && gridDim.x == 256;
#define IN(k) (lo <= (k) && (k) < hi)
#define SEAM(k) do { if (IN(k) && IN((k) + 1)) { xcd_barrier(xbar, wave == 0 && lane == 0); } } while (0)
    if (IN(0) && !(DIS & 1)) { phase0(p, lds, tid, lane, wave); if (DBL & 1) { __syncthreads(); phase0(p, lds, tid, lane, wave); } }
    SEAM(0);
    if (IN(1) && !(DIS & 2)) {
        pg8::Gemm g{(const bf16*)(ws + WS_XN), (const bf16*)(ws + WS_WIN), T_, NIN_, 1024}; pg8::StaticOrder S; S.init(T_, NIN_, gridDim.x, blockIdx.x);
        EpiIn E{ws};
        pg8::gemm_phase<EpiIn, pg8::StaticOrder, true, true>(ldsl, g, S, E, wave);
        if (DBL & 2) { __syncthreads(); pg8::gemm_phase<EpiIn, pg8::StaticOrder, true, true>(ldsl, g, S, E, wave); }
    }
    SEAM(1);
    if (IN(2) && !(DIS & 4)) phase2(p, lds, tid, lane, wave);
    SEAM(2);
    if (IN(3) && !(DIS & 8)) phase3(p, lds, tid, lane, wave);
    SEAM(3);
    if (IN(4) && !(DIS & 16)) {
        pg8::Gemm g{(const bf16*)(ws + WS_GR), (const bf16*)(ws + WS_WPG), T_, 1024, 1536}; pg8::StaticOrder S; S.init(T_, 1024, gridDim.x, blockIdx.x);
        EpiMixC E{(const bf16*)(ws + WS_MG), (const bf16*)(ws + WS_MN), (bf16*)(ws + WS_MIX)};
        pg8::gemm_phase<EpiMixC, pg8::StaticOrder, true, true>(ldsl, g, S, E, wave);
    }
    SEAM(4);
    if (IN(5) && !(DIS & 32)) {
        pg8::Gemm g{(const bf16*)(ws + WS_MIX), (const bf16*)(ws + WS_WOUT), T_, 1024, 1024}; pg8::StaticOrder S; S.init(T_, 1024, gridDim.x, blockIdx.x);
        if (fuse) {
            RmsPanel s1{(unsigned*)(ws + WS_XB), (unsigned*)(ws + WS_CTL) + CW_CNT}, s2{(unsigned*)(ws + WS_XB + 256 * 1024), (unsigned*)(ws + WS_CTL) + CW_CNT + 4096};
            EpiRmsResRms E{p->in[0], p->out, (bf16*)(ws + WS_XN2), p->in[2], p->in[3], s1, s2};
            pg8::gemm_phase<EpiRmsResRms, pg8::StaticOrder, false, true>(ldsl, g, S, E, wave);
        } else {
            EpiNorm E{(bf16*)(ws + WS_Y), (float*)(ws + WS_SS)};
            pg8::gemm_phase<EpiNorm, pg8::StaticOrder, true, true>(ldsl, g, S, E, wave);
        }
    }
    SEAM(5);
    if (!fuse) {
        if (IN(6) && !(DIS & 64)) rowpass_a(p, lane, wave);
        SEAM(6);
    }
    if (IN(7) && !(DIS & 128)) {
        pg8::Gemm g{(const bf16*)(ws + WS_XN2), (const bf16*)(ws + WS_WGU), T_, 2 * DFF_, 1024}; pg8::StaticOrder S; S.init(T_, 2 * DFF_, gridDim.x, blockIdx.x);
        EpiGU E{(bf16*)(ws + WS_HID)};
        pg8::gemm_phase<EpiGU, pg8::StaticOrder, true, true>(ldsl, g, S, E, wave);
        if (DBL & 128) { __syncthreads(); pg8::gemm_phase<EpiGU, pg8::StaticOrder, true, true>(ldsl, g, S, E, wave); }
    }
    SEAM(7);
    if (IN(8) && !(DIS & 256)) {
        pg8::Gemm g{(const bf16*)(ws + WS_HID), (const bf16*)(ws + WS_WD), T_, 1024, DFF_}; pg8::StaticOrder S; S.init(T_, 1024, gridDim.x, blockIdx.x);
        if (fuse) {
            RmsPanel s3{(unsigned*)(ws + WS_XB + 512 * 1024), (unsigned*)(ws + WS_CTL) + CW_CNT + 8192};
            EpiRmsRes E{p->out, p->in[4], s3};
            pg8::gemm_phase<EpiRmsRes, pg8::StaticOrder, false, true>(ldsl, g, S, E, wave);
        } else {
            EpiNorm E{(bf16*)(ws + WS_F), (float*)(ws + WS_SS)};
            pg8::gemm_phase<EpiNorm, pg8::StaticOrder, true, true>(ldsl, g, S, E, wave);
        }
    }
    if (!fuse) {
        SEAM(8);
        if (IN(9) && !(DIS & 512)) rowpass_b(p, lane, wave);
    }
#undef IN
#undef SEAM
#undef lane
#undef tid
}

#ifndef MK_SPLIT
#define MK_SPLIT 0
#endif
extern "C" void kernel_launch(void* const* d_in, const int* in_sizes, int n_in, void* d_out, int out_size, void* d_ws, size_t ws_size, hipStream_t stream) {
    static int grid = 0;
    if (grid == 0) {
        int dev = 0, cus = 0, per_cu = 0;
        hipGetDevice(&dev);
        hipDeviceGetAttribute(&cus, hipDeviceAttributeMultiprocessorCount, dev);
        if (hipFuncSetAttribute((const void*)fwd_kernel, hipFuncAttributeMaxDynamicSharedMemorySize, LDS_BYTES) != hipSuccess) { fprintf(stderr, "hipFuncSetAttribute failed\n"); }
        hipOccupancyMaxActiveBlocksPerMultiprocessor(&per_cu, (const void*)fwd_kernel, 512, LDS_BYTES);
        (void)hipGetLastError();
        if (per_cu < 1) per_cu = 1;
        grid = cus > 0 ? cus : 256;
        if (n_in != 21 || ws_size < 256 * MiB) fprintf(stderr, "kernel_launch: unexpected n_in %d / ws %zu\n", n_in, ws_size);
    }
    if (hipMemsetAsync((char*)d_ws + WS_CTL, 0, 98304, stream) != hipSuccess) fprintf(stderr, "memset failed\n");
    KP p{};
    for (int i = 0; i < 21; ++i) p.in[i] = (const float*)d_in[i];
    p.out = (float*)d_out; p.ws = (unsigned char*)d_ws;
#if MK_SPLIT
    for (int ph = 0; ph < NPHASE; ++ph) {
        p.ph_lo = ph; p.ph_hi = ph + 1;
        hipLaunchKernelGGL(fwd_kernel, dim3(grid), dim3(512), LDS_BYTES, stream, p);
    }
#else
    p.ph_lo = 0; p.ph_hi = NPHASE;
    void* args[] = {&p};
    hipError_t e = hipLaunchCooperativeKernel((const void*)fwd_kernel, dim3(grid), dim3(512), args, LDS_BYTES, stream);
    if (e != hipSuccess) fprintf(stderr, "cooperative launch failed: %s (grid %d)\n", hipGetErrorString(e), grid);
#endif
}
```

```cpp
#include <hip/hip_runtime.h>
#include <hip/hip_cooperative_groups.h>
#include <cstdio>
#include <cstdint>
namespace cg = cooperative_groups;
#ifndef DIS
#define DIS 0
#endif
#ifndef DBL
#define DBL 0
#endif
namespace pg8 {
#define PG8_LAS __attribute__((address_space(3)))
typedef unsigned short bf16_t;
typedef short bf16x8 __attribute__((ext_vector_type(8)));
typedef float f32x4 __attribute__((ext_vector_type(4)));
typedef unsigned u32x4 __attribute__((ext_vector_type(4)));
constexpr int BM = 256, BK = 64, HALF = 128, HTB = HALF * BK * 2  , STAGE_BYTES = 8 * HTB, NXCD = 8, WGM = 8;

__host__ __device__ __forceinline__ int lds_byte(int r, int c) { const int st = (r >> 4) * 2 + (c >> 5), rr = r & 15, cc = c & 31, ob = rr * 64 + cc * 2; return st * 1024 + (ob ^ (((ob >> 9) & 1) << 5)); }
__host__ __device__ __forceinline__ void stage_rc(int b, int& R, int& C) { const int st = b / 1024, sb = b % 1024, swz = sb ^ (((sb >> 9) & 1) << 5); R = (st >> 1) * 16 + swz / 64; C = (st & 1) * 32 + (swz % 64) / 2; }
__host__ __device__ __forceinline__ int perm32(int rho) { const int n = rho >> 4, i = rho & 15; return 8 * (i >> 2) + 4 * n + (i & 3); }

struct Unit { int pm, pn; };
struct Gemm { const bf16_t* A; const bf16_t* Bt; int M, N, K; };

struct StaticOrder {
    int nM, nN, nwg, G, c;
    __host__ __device__ void init(int M, int N, int G_, int c_) { nM = M / BM; nN = N / BM; nwg = nM * nN; G = G_; c = c_; }
    __host__ __device__ bool next(int i, Unit& u) const {
        const long L = (long)i * G + c; if (L >= nwg) return false;
        int wgid = (int)L; { const int q = nwg / NXCD, r = nwg % NXCD, xcd = wgid % NXCD, off = wgid / NXCD; wgid = (xcd < r ? xcd * (q + 1) : r * (q + 1) + (xcd - r) * q) + off; }
        const int nig = WGM * nN, gid = wgid / nig, fm = gid * WGM, gsz = (nM - fm) < WGM ? (nM - fm) : WGM;
        u.pm = fm + ((wgid % nig) % gsz); u.pn = (wgid % nig) / gsz; return true;
    }
    __device__ __forceinline__ void a_ready(const Unit&) const {}
    __device__ __forceinline__ void done(const Unit&) const {}
};

__device__ __forceinline__ unsigned cvt_pk_bf16(float lo, float hi) { unsigned r; asm volatile("v_cvt_pk_bf16_f32 %0, %1, %2" : "=v"(r) : "v"(lo), "v"(hi)); return r; }
template <class Epi, class Sched, bool ALIGN_EPI = false, bool SP2 = false>
__device__ __forceinline__ void gemm_phase(PG8_LAS unsigned char* lds, const Gemm g, const Sched& S, const Epi& E, const int wid) {
    const int lane = (int)__builtin_amdgcn_mbcnt_hi(~0u, __builtin_amdgcn_mbcnt_lo(~0u, 0u)), tid = wid * 64 + lane, wr = wid >> 2, wc = wid & 3, fr = lane & 15, fq = lane >> 4;
    const int K = g.K, nt = K / BK;
    unsigned voffA[2], voffB[2];
#pragma unroll
    for (int i = 0; i < 2; ++i) { int R, C; stage_rc(tid * 16 + i * 8192, R, C); const int Rb = Epi::PERM ? ((R & ~31) + perm32(R & 31)) : R;
        voffA[i] = (unsigned)(R * K + C) * 2u; voffB[i] = (unsigned)(Rb * K + C) * 2u; }
    const size_t kstep = (size_t)(BK * 2);
    const size_t hstep = (size_t)HALF * K * 2;
    const size_t tstep = 2 * hstep;
    const unsigned ldsw = (unsigned)wid * 1024u;
    const int aoff = lds_byte(wr * 64 + fr, fq * 8), boff = lds_byte(wc * 32 + fr, fq * 8);
#define PG8_SA(b, h) (((b) * 2 + (h)) * HTB)
#define PG8_SB(b, h) ((4 + (b) * 2 + (h)) * HTB)
#define PG8_STAGE(bufoff, gbase, voff) do { _Pragma("unroll") for (int _i = 0; _i < 2; ++_i) \
        __builtin_amdgcn_global_load_lds((const unsigned*)((const char*)(gbase) + (voff)[_i]), (PG8_LAS unsigned*)(lds + (bufoff) + ldsw + _i * 8192), 16, 0, 0); } while (0)
#define PG8_LDA(dst, b, h) do { _Pragma("unroll") for (int m = 0; m < 4; ++m) _Pragma("unroll") for (int k = 0; k < 2; ++k) dst[m][k] = *(const PG8_LAS bf16x8*)(lds + PG8_SA(b, h) + aoff + m * 2048 + k * 1024); } while (0)
#define PG8_LDB(dst, b, h) do { _Pragma("unroll") for (int n = 0; n < 2; ++n) _Pragma("unroll") for (int k = 0; k < 2; ++k) dst[n][k] = *(const PG8_LAS bf16x8*)(lds + PG8_SB(b, h) + boff + n * 2048 + k * 1024); } while (0)
#define PG8_MMA(ai, bj, At, Bt) do { __builtin_amdgcn_s_setprio(1); _Pragma("unroll") for (int m = 0; m < 4; ++m) _Pragma("unroll") for (int n = 0; n < 2; ++n) _Pragma("unroll") for (int k = 0; k < 2; ++k) \
        acc[ai][bj][m][n] = __builtin_amdgcn_mfma_f32_16x16x32_bf16(Bt[n][k], At[m][k], acc[ai][bj][m][n], 0, 0, 0); __builtin_amdgcn_s_setprio(0); } while (0)
#define PG8_WAIT_V(n) asm volatile("s_waitcnt vmcnt(" #n ")" ::: "memory")
#define PG8_WAIT_L(n) asm volatile("s_waitcnt lgkmcnt(" #n ")" ::: "memory")
#define PG8_BAR __builtin_amdgcn_s_barrier()
#define PG8_SCHED __builtin_amdgcn_sched_barrier(0)
    Unit cur, nxt; int ui = 0;
    if (!S.next(0, cur)) return;
    f32x4 acc[2][2][4][2];
#pragma unroll
    for (int a = 0; a < 2; ++a)
#pragma unroll
        for (int b = 0; b < 2; ++b)
#pragma unroll
            for (int m = 0; m < 4; ++m)
#pragma unroll
                for (int n = 0; n < 2; ++n) acc[a][b][m][n] = (f32x4){0.f, 0.f, 0.f, 0.f};
    bf16x8 At[4][2], B0[2][2], B1[2][2];
    const char* cA = (const char*)g.A + (size_t)cur.pm * tstep; const char* cB = (const char*)g.Bt + (size_t)cur.pn * tstep;
    S.a_ready(cur);
    if constexpr (SP2) {
        PG8_STAGE(PG8_SB(0, 0), cB, voffB); PG8_STAGE(PG8_SB(0, 1), cB + hstep, voffB); PG8_STAGE(PG8_SA(0, 0), cA, voffA); PG8_STAGE(PG8_SA(0, 1), cA + hstep, voffA);
        if (wr == 1) PG8_BAR;
        PG8_WAIT_V(2); PG8_BAR;
        PG8_STAGE(PG8_SB(1, 0), cB + kstep, voffB); PG8_STAGE(PG8_SA(1, 0), cA + kstep, voffA); PG8_STAGE(PG8_SB(1, 1), cB + hstep + kstep, voffB);
        PG8_WAIT_V(6); PG8_BAR;
    } else {
        PG8_STAGE(PG8_SB(0, 0), cB, voffB); PG8_STAGE(PG8_SA(0, 0), cA, voffA); PG8_STAGE(PG8_SB(0, 1), cB + hstep, voffB); PG8_STAGE(PG8_SA(0, 1), cA + hstep, voffA);
        if (wr == 1) PG8_BAR;
        PG8_WAIT_V(4); PG8_BAR;
        PG8_STAGE(PG8_SB(1, 0), cB + kstep, voffB); PG8_STAGE(PG8_SA(1, 0), cA + kstep, voffA); PG8_STAGE(PG8_SB(1, 1), cB + hstep + kstep, voffB);
        PG8_WAIT_V(6); PG8_BAR;
    }
    for (;;) {
        const bool has_next = S.next(ui + 1, nxt);
        const char* nA = has_next ? (const char*)g.A + (size_t)nxt.pm * tstep : cA; const char* nB = has_next ? (const char*)g.Bt + (size_t)nxt.pn * tstep : cB;
        for (int t = 0; t < nt; t += 2) {
            if constexpr (Epi::MID_T >= 0) { if (t == Epi::MID_T) E.mid(acc, cur, wr, wc, fr, fq); }
            const bool last = (t == nt - 2);
            const char* a1 = cA + (size_t)(t + 1) * kstep;
            const char* a2 = last ? nA : cA + (size_t)(t + 2) * kstep; const char* b2 = last ? nB : cB + (size_t)(t + 2) * kstep;
            const char* a3 = a2 + kstep; const char* b3 = b2 + kstep;
            if (last && has_next) S.a_ready(nxt);
            if constexpr (SP2) {
            PG8_LDB(B0, 0, 0); PG8_LDB(B1, 0, 1); PG8_SCHED; PG8_LDA(At, 0, 0); PG8_STAGE(PG8_SA(1, 1), a1 + hstep, voffA);
            PG8_WAIT_V(8); PG8_WAIT_L(0); PG8_BAR; PG8_MMA(0, 0, At, B0); PG8_MMA(0, 1, At, B1); PG8_BAR; PG8_SCHED;
            PG8_LDA(At, 0, 1); PG8_STAGE(PG8_SB(0, 0), b2, voffB); PG8_STAGE(PG8_SB(0, 1), b2 + hstep, voffB); PG8_STAGE(PG8_SA(0, 0), a2, voffA);
            PG8_WAIT_V(8); PG8_WAIT_L(0); PG8_BAR; PG8_MMA(1, 0, At, B0); PG8_MMA(1, 1, At, B1); PG8_BAR; PG8_SCHED;
            PG8_LDB(B0, 1, 0); PG8_LDB(B1, 1, 1); PG8_SCHED; PG8_LDA(At, 1, 0); PG8_STAGE(PG8_SA(0, 1), a2 + hstep, voffA);
            PG8_WAIT_V(8); PG8_WAIT_L(0); PG8_BAR; PG8_MMA(0, 0, At, B0); PG8_MMA(0, 1, At, B1); PG8_BAR; PG8_SCHED;
            PG8_LDA(At, 1, 1); PG8_STAGE(PG8_SB(1, 0), b3, voffB); PG8_STAGE(PG8_SB(1, 1), b3 + hstep, voffB); PG8_STAGE(PG8_SA(1, 0), a3, voffA);
            PG8_WAIT_V(8); PG8_WAIT_L(0); PG8_BAR; PG8_MMA(1, 0, At, B0); PG8_MMA(1, 1, At, B1); PG8_BAR; PG8_SCHED;
            } else {
            PG8_LDB(B0, 0, 0); PG8_SCHED; PG8_LDA(At, 0, 0); PG8_STAGE(PG8_SA(1, 1), a1 + hstep, voffA);
            PG8_WAIT_L(8); PG8_BAR; PG8_WAIT_L(0); PG8_MMA(0, 0, At, B0); PG8_BAR; PG8_SCHED;
            PG8_LDB(B1, 0, 1); PG8_STAGE(PG8_SB(0, 0), b2, voffB);
            PG8_BAR; PG8_WAIT_L(0); PG8_MMA(0, 1, At, B1); PG8_BAR;
            PG8_LDA(At, 0, 1); PG8_STAGE(PG8_SA(0, 0), a2, voffA);
            PG8_BAR; PG8_WAIT_L(0); PG8_MMA(1, 0, At, B0); PG8_BAR; PG8_SCHED;
            PG8_STAGE(PG8_SB(0, 1), b2 + hstep, voffB);
            PG8_WAIT_V(6); PG8_BAR; PG8_MMA(1, 1, At, B1); PG8_BAR;
            PG8_LDB(B0, 1, 0); PG8_SCHED; PG8_LDA(At, 1, 0); PG8_STAGE(PG8_SA(0, 1), a2 + hstep, voffA);
            PG8_WAIT_L(8); PG8_BAR; PG8_WAIT_L(0); PG8_MMA(0, 0, At, B0); PG8_BAR; PG8_SCHED;
            PG8_LDB(B1, 1, 1); PG8_STAGE(PG8_SB(1, 0), b3, voffB);
            PG8_BAR; PG8_WAIT_L(0); PG8_MMA(0, 1, At, B1); PG8_BAR;
            PG8_LDA(At, 1, 1); PG8_STAGE(PG8_SA(1, 0), a3, voffA);
            PG8_BAR; PG8_WAIT_L(0); PG8_MMA(1, 0, At, B0); PG8_BAR; PG8_SCHED;
            PG8_STAGE(PG8_SB(1, 1), b3 + hstep, voffB);
            PG8_WAIT_V(6); PG8_BAR; PG8_MMA(1, 1, At, B1); PG8_BAR;
            }
        }
        if constexpr (ALIGN_EPI) { if (wr == 0) PG8_BAR; }
        if constexpr (!Epi::AFTER_DRAIN) { E(acc, cur, wr, wc, fr, fq); S.done(cur); }
        if (!has_next) break;
#pragma unroll
        for (int a = 0; a < 2; ++a)
#pragma unroll
            for (int b = 0; b < 2; ++b)
#pragma unroll
                for (int m = 0; m < 4; ++m)
#pragma unroll
                    for (int n = 0; n < 2; ++n) acc[a][b][m][n] = (f32x4){0.f, 0.f, 0.f, 0.f};
        cur = nxt; cA = nA; cB = nB; ++ui;
        if constexpr (ALIGN_EPI) { if (wr == 1) PG8_BAR; }
    }
    PG8_WAIT_V(0);
    if constexpr (!ALIGN_EPI) { if (wr == 0) PG8_BAR; }
    PG8_BAR;
    if constexpr (Epi::AFTER_DRAIN) { E.fused(acc, cur, wr, wc, fr, fq, lds, wid, lane); S.done(cur); }
#undef PG8_SA
#undef PG8_SB
#undef PG8_STAGE
#undef PG8_LDA
#undef PG8_LDB
#undef PG8_MMA
#undef PG8_WAIT_V
#undef PG8_WAIT_L
#undef PG8_BAR
#undef PG8_SCHED
}
}

typedef unsigned short bf16;
typedef short bf16x8 __attribute__((ext_vector_type(8)));
typedef float f32x4 __attribute__((ext_vector_type(4)));
typedef float f32x16 __attribute__((ext_vector_type(16)));
typedef unsigned u32x4 __attribute__((ext_vector_type(4)));
typedef unsigned u32x2 __attribute__((ext_vector_type(2)));
typedef float f32x2_t __attribute__((ext_vector_type(2)));
typedef __bf16 bf16x2_t __attribute__((ext_vector_type(2)));

constexpr int T_ = 16384, S_ = 4096, DM_ = 1024, DFF_ = 2816, NIN_ = 6656;
constexpr float LOG2E = 1.4426950408889634f;
constexpr float QC2 = 0.125f * LOG2E;
constexpr float RMS_EPS = 1e-6f;
constexpr size_t MiB = 1u << 20;
constexpr size_t WS_CTL = 0;
constexpr size_t WS_DEC = 1 * MiB;
constexpr size_t WS_KCB = 1 * MiB + 512 * 1024;
constexpr size_t WS_VCB = WS_KCB + 256 * 1024;
constexpr size_t WS_W1T = 2 * MiB;
constexpr size_t WS_PEW = 2 * MiB + 512 * 1024;
constexpr size_t WS_SS = 3 * MiB;
constexpr size_t WS_WIN = 4 * MiB;
constexpr size_t WS_WGU = 4 * MiB;
constexpr size_t WS_WPG = 17 * MiB, WS_WPN = 19 * MiB, WS_WOUT = 20 * MiB;
constexpr size_t WS_XN = 22 * MiB;
constexpr size_t WS_KD = 22 * MiB, WS_WD = 38 * MiB;
constexpr size_t WS_GQ = 54 * MiB, WS_GK = 70 * MiB, WS_GV = 86 * MiB, WS_GR = 118 * MiB, WS_NQ = 150 * MiB, WS_NKV = 166 * MiB;
constexpr size_t WS_MG = 190 * MiB, WS_MN = 222 * MiB, WS_GSM = 254 * MiB;
constexpr size_t WS_MIX = 86 * MiB, WS_Y = 54 * MiB, WS_XN2 = 118 * MiB, WS_HID = 150 * MiB, WS_F = 54 * MiB;
constexpr int LDS_BYTES = 147456;

__device__ __forceinline__ unsigned pk2(float lo, float hi) { f32x2_t v = {lo, hi}; bf16x2_t b = __builtin_convertvector(v, bf16x2_t); return __builtin_bit_cast(unsigned, b); }
__device__ __forceinline__ bf16 f2bf(float f) { return (bf16)(pk2(f, 0.f) & 0xffffu); }
__device__ __forceinline__ float bf2f(unsigned b) { return __uint_as_float(b << 16); }
__device__ __forceinline__ float bflo(unsigned w) { return __uint_as_float(w << 16); }
__device__ __forceinline__ float bfhi(unsigned w) { return __uint_as_float(w & 0xffff0000u); }
__device__ __forceinline__ float sigmoidf_(float x) { return __builtin_amdgcn_rcpf(1.f + __expf(-x)); }
__device__ __forceinline__ float siluf_(float x) { return x * __builtin_amdgcn_rcpf(1.f + __expf(-x)); }
__device__ __forceinline__ float wave_sum(float v) {
#pragma unroll
    for (int o = 1; o < 64; o <<= 1) v += __shfl_xor(v, o);
    return v;
}
__device__ __forceinline__ int crow(int r, int hi) { return (r & 3) + 8 * (r >> 2) + 4 * hi; }
__device__ __forceinline__ bf16x8 mk8(u32x2 a, u32x2 b) { u32x4 v = {a.x, a.y, b.x, b.y}; return __builtin_bit_cast(bf16x8, v); }
#define MFMA32(a, b, c) __builtin_amdgcn_mfma_f32_32x32x16_bf16((a), (b), (c), 0, 0, 0)

using pg8::Unit;
struct EpiIn {
    static constexpr bool PERM = true, AFTER_DRAIN = false; static constexpr int MID_T = -1;
    unsigned char* ws;
    __device__ __forceinline__ void operator()(const pg8::f32x4 (&acc)[2][2][4][2], const Unit& u, int wr, int wc, int fr, int fq) const {
        const int pn = u.pn; size_t off; int ld, ct; float sc = 1.f;
        if (pn < 2) { off = WS_GQ; ld = 512; ct = pn; }
        else if (pn < 4) { off = WS_GK; ld = 512; ct = pn - 2; }
        else if (pn < 8) { off = WS_GV; ld = 1024; ct = pn - 4; }
        else if (pn < 12) { off = WS_GR; ld = 1536; ct = pn - 8; }
        else if (pn < 14) { off = WS_GR + 2048; ld = 1536; ct = pn - 12; sc = QC2; }
        else if (pn < 17) { off = WS_NKV; ld = 768; ct = pn - 14; }
        else if (pn < 21) { off = WS_MG; ld = 1024; ct = pn - 17; }
        else if (pn < 25) { off = WS_MN; ld = 1024; ct = pn - 21; }
        else { off = WS_GSM; ld = 64; ct = 0; }
        bf16* base = (bf16*)(ws + off);
        const int row0 = u.pm * 256 + wr * 64 + fr;
#pragma unroll
        for (int ai = 0; ai < 2; ++ai)
#pragma unroll
            for (int m = 0; m < 4; ++m) {
                const int row = row0 + ai * 128 + m * 16;
#pragma unroll
                for (int bj = 0; bj < 2; ++bj) {
                    if (pn == 25 && (bj != 0 || wc >= 2)) continue;
                    const int col = ct * 256 + bj * 128 + wc * 32 + 8 * fq;
                    const pg8::f32x4 v0 = acc[ai][bj][m][0] * sc, v1 = acc[ai][bj][m][1] * sc;
                    u32x4 w; w.x = pk2(v0[0], v0[1]); w.y = pk2(v0[2], v0[3]); w.z = pk2(v1[0], v1[1]); w.w = pk2(v1[2], v1[3]);
                    *(u32x4*)(base + (size_t)row * ld + col) = w;
                }
            }
    }
};
template <bool ADD> struct EpiMix {
    static constexpr bool PERM = true, AFTER_DRAIN = false; static constexpr int MID_T = -1;
    const bf16* gate; bf16* out;
    __device__ __forceinline__ void operator()(const pg8::f32x4 (&acc)[2][2][4][2], const Unit& u, int wr, int wc, int fr, int fq) const {
        const int row0 = u.pm * 256 + wr * 64 + fr;
#pragma unroll
        for (int ai = 0; ai < 2; ++ai)
#pragma unroll
            for (int m = 0; m < 4; ++m) {
                const int row = row0 + ai * 128 + m * 16;
#pragma unroll
                for (int bj = 0; bj < 2; ++bj) {
                    const int col = u.pn * 256 + bj * 128 + wc * 32 + 8 * fq;
                    const size_t o = (size_t)row * 1024 + col;
                    const u32x4 gw = *(const u32x4*)(gate + o);
                    const pg8::f32x4 a0 = acc[ai][bj][m][0], a1 = acc[ai][bj][m][1];
                    float v[8];
                    v[0] = sigmoidf_(bflo(gw.x)) * a0[0]; v[1] = sigmoidf_(bfhi(gw.x)) * a0[1];
                    v[2] = sigmoidf_(bflo(gw.y)) * a0[2]; v[3] = sigmoidf_(bfhi(gw.y)) * a0[3];
                    v[4] = sigmoidf_(bflo(gw.z)) * a1[0]; v[5] = sigmoidf_(bfhi(gw.z)) * a1[1];
                    v[6] = sigmoidf_(bflo(gw.w)) * a1[2]; v[7] = sigmoidf_(bfhi(gw.w)) * a1[3];
                    if (ADD) {
                        const u32x4 pw = *(const u32x4*)(out + o);
                        v[0] += bflo(pw.x); v[1] += bfhi(pw.x); v[2] += bflo(pw.y); v[3] += bfhi(pw.y);
                        v[4] += bflo(pw.z); v[5] += bfhi(pw.z); v[6] += bflo(pw.w); v[7] += bfhi(pw.w);
                    }
                    u32x4 w; w.x = pk2(v[0], v[1]); w.y = pk2(v[2], v[3]); w.z = pk2(v[4], v[5]); w.w = pk2(v[6], v[7]);
                    *(u32x4*)(out + o) = w;
                }
            }
    }
};
struct EpiMixC {
    static constexpr bool PERM = true, AFTER_DRAIN = false; static constexpr int MID_T = 16;
    const bf16* mg; const bf16* mn; bf16* out;
    __device__ __forceinline__ void mid(pg8::f32x4 (&acc)[2][2][4][2], const Unit& u, int wr, int wc, int fr, int fq) const {
        int row0 = u.pm * 256 + wr * 64 + fr; asm volatile("" : "+v"(row0));
        int fq8 = 8 * fq; asm volatile("" : "+v"(fq8));
#pragma unroll
        for (int ai = 0; ai < 2; ++ai) {
            u32x4 ga[4][2], gb[4][2];
#pragma unroll
            for (int m = 0; m < 4; ++m)
#pragma unroll
                for (int bj = 0; bj < 2; ++bj) {
                    const size_t o = (size_t)(row0 + ai * 128 + m * 16) * 1024 + u.pn * 256 + bj * 128 + wc * 32 + fq8;
                    ga[m][bj] = *(const u32x4*)(mg + o); gb[m][bj] = *(const u32x4*)(mn + o);
                }
#pragma unroll
            for (int m = 0; m < 4; ++m)
#pragma unroll
                for (int bj = 0; bj < 2; ++bj) {
                    const unsigned aw[4] = {ga[m][bj].x, ga[m][bj].y, ga[m][bj].z, ga[m][bj].w}, bw[4] = {gb[m][bj].x, gb[m][bj].y, gb[m][bj].z, gb[m][bj].w};
#pragma unroll
                    for (int e = 0; e < 4; ++e) {
                        const float r0 = (1.f + __expf(-bflo(bw[e]))) * __builtin_amdgcn_rcpf(1.f + __expf(-bflo(aw[e])));
                        const float r1 = (1.f + __expf(-bfhi(bw[e]))) * __builtin_amdgcn_rcpf(1.f + __expf(-bfhi(aw[e])));
                        acc[ai][bj][m][e >> 1][(e & 1) * 2 + 0] *= r0; acc[ai][bj][m][e >> 1][(e & 1) * 2 + 1] *= r1;
                    }
                }
            asm volatile("" ::: "memory");
        }
    }
    __device__ __forceinline__ void operator()(const pg8::f32x4 (&acc)[2][2][4][2], const Unit& u, int wr, int wc, int fr, int fq) const {
        const int row0 = u.pm * 256 + wr * 64 + fr;
#pragma unroll
        for (int ai = 0; ai < 2; ++ai)
#pragma unroll
            for (int m = 0; m < 4; ++m) {
                const int row = row0 + ai * 128 + m * 16;
#pragma unroll
                for (int bj = 0; bj < 2; ++bj) {
                    const size_t o = (size_t)row * 1024 + u.pn * 256 + bj * 128 + wc * 32 + 8 * fq;
                    const u32x4 gw = *(const u32x4*)(mn + o);
                    const pg8::f32x4 a0 = acc[ai][bj][m][0], a1 = acc[ai][bj][m][1];
                    u32x4 w;
                    w.x = pk2(sigmoidf_(bflo(gw.x)) * a0[0], sigmoidf_(bfhi(gw.x)) * a0[1]); w.y = pk2(sigmoidf_(bflo(gw.y)) * a0[2], sigmoidf_(bfhi(gw.y)) * a0[3]);
                    w.z = pk2(sigmoidf_(bflo(gw.z)) * a1[0], sigmoidf_(bfhi(gw.z)) * a1[1]); w.w = pk2(sigmoidf_(bflo(gw.w)) * a1[2], sigmoidf_(bfhi(gw.w)) * a1[3]);
                    *(u32x4*)(out + o) = w;
                }
            }
    }
};
struct EpiNorm {
    static constexpr bool PERM = true, AFTER_DRAIN = false; static constexpr int MID_T = -1;
    bf16* out; float* ss;
    __device__ __forceinline__ void operator()(const pg8::f32x4 (&acc)[2][2][4][2], const Unit& u, int wr, int wc, int fr, int fq) const {
        const int row0 = u.pm * 256 + wr * 64 + fr;
#pragma unroll
        for (int ai = 0; ai < 2; ++ai)
#pragma unroll
            for (int m = 0; m < 4; ++m) {
                const int row = row0 + ai * 128 + m * 16;
                float s = 0.f;
#pragma unroll
                for (int bj = 0; bj < 2; ++bj) {
                    const int col = u.pn * 256 + bj * 128 + wc * 32 + 8 * fq;
                    const pg8::f32x4 v0 = acc[ai][bj][m][0], v1 = acc[ai][bj][m][1];
                    s += v0[0] * v0[0] + v0[1] * v0[1] + v0[2] * v0[2] + v0[3] * v0[3] + v1[0] * v1[0] + v1[1] * v1[1] + v1[2] * v1[2] + v1[3] * v1[3];
                    u32x4 w; w.x = pk2(v0[0], v0[1]); w.y = pk2(v0[2], v0[3]); w.z = pk2(v1[0], v1[1]); w.w = pk2(v1[2], v1[3]);
                    *(u32x4*)(out + (size_t)row * 1024 + col) = w;
                }
                s += __shfl_xor(s, 16); s += __shfl_xor(s, 32);
                if (fq == 0) ss[(size_t)row * 16 + u.pn * 4 + wc] = s;
            }
    }
};
struct EpiGU {
    static constexpr bool PERM = true, AFTER_DRAIN = false; static constexpr int MID_T = -1;
    bf16* out;
    __device__ __forceinline__ void operator()(const pg8::f32x4 (&acc)[2][2][4][2], const Unit& u, int wr, int wc, int fr, int fq) const {
        const int row0 = u.pm * 256 + wr * 64 + fr;
#pragma unroll
        for (int ai = 0; ai < 2; ++ai)
#pragma unroll
            for (int m = 0; m < 4; ++m) {
                const int row = row0 + ai * 128 + m * 16;
#pragma unroll
                for (int bj = 0; bj < 2; ++bj) {
                    const int col = u.pn * 256 + bj * 128 + wc * 32 + 8 * fq;
                    const pg8::f32x4 v0 = acc[ai][bj][m][0], v1 = acc[ai][bj][m][1];
                    u32x2 w; w.x = pk2(siluf_(v0[0]) * v0[1], siluf_(v0[2]) * v0[3]); w.y = pk2(siluf_(v1[0]) * v1[1], siluf_(v1[2]) * v1[3]);
                    *(u32x2*)(out + (size_t)row * DFF_ + (col >> 1)) = w;
                }
            }
    }
};

constexpr size_t WS_XB = 52 * MiB + 512 * 1024;
constexpr int CW_CNT = 8192;
struct RmsPanel {
    unsigned* xbuf; unsigned* cnt;
    __device__ __forceinline__ void run(const pg8::f32x4 (&v)[2][2][4][2], const Unit& u, int wr, int wc, int fr, int fq, PG8_LAS unsigned char* lds, int wid, int lane) const {
        PG8_LAS float* P = (PG8_LAS float*)lds;
        PG8_LAS float* S = (PG8_LAS float*)(lds + 8192);
#pragma unroll
        for (int ai = 0; ai < 2; ++ai)
#pragma unroll
            for (int m = 0; m < 4; ++m) {
                float q = 0.f;
#pragma unroll
                for (int bj = 0; bj < 2; ++bj)
#pragma unroll
                    for (int n = 0; n < 2; ++n) { const pg8::f32x4 x = v[ai][bj][m][n]; q += (x[0] * x[0] + x[1] * x[1]) + (x[2] * x[2] + x[3] * x[3]); }
                q += __shfl_xor(q, 16); q += __shfl_xor(q, 32);
                if (fq == 0) P[(ai * 128 + wr * 64 + m * 16 + fr) * 4 + wc] = q;
            }
        asm volatile("s_waitcnt lgkmcnt(0)" ::: "memory"); __builtin_amdgcn_s_barrier(); asm volatile("" ::: "memory");
        const int row = wid * 32 + (lane & 31);
        if (lane < 32) {
            const float t = (P[row * 4 + 0] + P[row * 4 + 1]) + (P[row * 4 + 2] + P[row * 4 + 3]);
            __hip_atomic_store(xbuf + ((size_t)(u.pm * 256 + row) * 4 + u.pn), __float_as_uint(t), __ATOMIC_RELAXED, __HIP_MEMORY_SCOPE_AGENT);
        }
        asm volatile("s_waitcnt vmcnt(0)" ::: "memory");
        if (lane == 0) __hip_atomic_fetch_add(cnt + 64 * u.pm, 1u, __ATOMIC_RELAXED, __HIP_MEMORY_SCOPE_AGENT);
        if (wid == 0) {
            unsigned spins = 0;
            while ((unsigned)__builtin_amdgcn_readfirstlane(__hip_atomic_load(cnt + 64 * u.pm, __ATOMIC_RELAXED, __HIP_MEMORY_SCOPE_AGENT)) < 32u) { __builtin_amdgcn_s_sleep(2); if (++spins > (1u << 22)) break; }
            __builtin_amdgcn_fence(__ATOMIC_ACQUIRE, "agent");
        }
        asm volatile("s_waitcnt vmcnt(0) lgkmcnt(0)" ::: "memory"); __builtin_amdgcn_s_barrier(); asm volatile("" ::: "memory");
        if (lane < 32) {
            const unsigned* slot = xbuf + (size_t)(u.pm * 256 + row) * 4;
            float t = 0.f;
#pragma unroll
            for (int k = 0; k < 4; ++k) t += __uint_as_float(__hip_atomic_load(slot + k, __ATOMIC_RELAXED, __HIP_MEMORY_SCOPE_AGENT));
            S[row] = rsqrtf(t * (1.f / 1024.f) + RMS_EPS);
        }
        asm volatile("s_waitcnt vmcnt(0) lgkmcnt(0)" ::: "memory"); __builtin_amdgcn_s_barrier(); asm volatile("" ::: "memory");
    }
};
struct EpiRmsResRms {
    static constexpr bool PERM = false, AFTER_DRAIN = true; static constexpr int MID_T = -1;
    const float* x; float* out; bf16* xn; const float* g1; const float* g2; RmsPanel st1, st2;
    __device__ __forceinline__ void fused(pg8::f32x4 (&acc)[2][2][4][2], const Unit& u, int wr, int wc, int fr, int fq, PG8_LAS unsigned char* lds, int wid, int lane) const {
        const PG8_LAS float* S = (const PG8_LAS float*)(lds + 8192);
        const int col0 = u.pn * 256 + wc * 32 + 4 * fq;
        pg8::f32x4 pre[4][2][2];
#pragma unroll
        for (int m = 0; m < 4; ++m) { const size_t off = (size_t)(u.pm * 256 + wr * 64 + m * 16 + fr) * 1024 + col0;
#pragma unroll
            for (int bj = 0; bj < 2; ++bj)
#pragma unroll
                for (int n = 0; n < 2; ++n) pre[m][bj][n] = *(const pg8::f32x4*)(x + off + bj * 128 + n * 16); }
        st1.run(acc, u, wr, wc, fr, fq, lds, wid, lane);
        {
            pg8::f32x4 gv[2][2];
#pragma unroll
            for (int bj = 0; bj < 2; ++bj)
#pragma unroll
                for (int n = 0; n < 2; ++n) gv[bj][n] = *(const pg8::f32x4*)(g1 + col0 + bj * 128 + n * 16);
#pragma unroll
            for (int ai = 0; ai < 2; ++ai)
#pragma unroll
                for (int m = 0; m < 4; ++m) {
                    const int r = ai * 128 + wr * 64 + m * 16 + fr; const float sr = S[r]; const size_t off = (size_t)(u.pm * 256 + r) * 1024 + col0;
#pragma unroll
                    for (int bj = 0; bj < 2; ++bj)
#pragma unroll
                        for (int n = 0; n < 2; ++n) { const pg8::f32x4 xs = (ai == 0) ? pre[m][bj][n] : *(const pg8::f32x4*)(x + off + bj * 128 + n * 16); acc[ai][bj][m][n] = xs + acc[ai][bj][m][n] * sr * gv[bj][n]; }
                    asm volatile("" : "+v"(acc[ai][0][m][0]), "+v"(acc[ai][0][m][1]), "+v"(acc[ai][1][m][0]), "+v"(acc[ai][1][m][1]));
                    if (m & 1) asm volatile("" ::: "memory");
                }
        }
        st2.run(acc, u, wr, wc, fr, fq, lds, wid, lane);
        {
            pg8::f32x4 gv[2][2];
#pragma unroll
            for (int bj = 0; bj < 2; ++bj)
#pragma unroll
                for (int n = 0; n < 2; ++n) gv[bj][n] = *(const pg8::f32x4*)(g2 + col0 + bj * 128 + n * 16);
#pragma unroll
            for (int ai = 0; ai < 2; ++ai)
#pragma unroll
                for (int m = 0; m < 4; ++m) {
                    const int r = ai * 128 + wr * 64 + m * 16 + fr; const float sr = S[r]; const size_t off = (size_t)(u.pm * 256 + r) * 1024 + col0;
#pragma unroll
                    for (int bj = 0; bj < 2; ++bj)
#pragma unroll
                        for (int n = 0; n < 2; ++n) {
                            const pg8::f32x4 x1 = acc[ai][bj][m][n];
                            *(pg8::f32x4*)(out + off + bj * 128 + n * 16) = x1;
                            const pg8::f32x4 o = x1 * sr * gv[bj][n];
                            u32x2 w; w.x = pk2(o[0], o[1]); w.y = pk2(o[2], o[3]);
                            *(u32x2*)(xn + off + bj * 128 + n * 16) = w;
                        }
                    asm volatile("" ::: "memory");
                }
        }
    }
};
struct EpiRmsRes {
    static constexpr bool PERM = false, AFTER_DRAIN = true; static constexpr int MID_T = -1;
    float* out; const float* g; RmsPanel st;
    __device__ __forceinline__ void fused(pg8::f32x4 (&acc)[2][2][4][2], const Unit& u, int wr, int wc, int fr, int fq, PG8_LAS unsigned char* lds, int wid, int lane) const {
        const PG8_LAS float* S = (const PG8_LAS float*)(lds + 8192);
        const int col0 = u.pn * 256 + wc * 32 + 4 * fq;
        pg8::f32x4 pre[4][2][2];
#pragma unroll
        for (int m = 0; m < 4; ++m) { const size_t off = (size_t)(u.pm * 256 + wr * 64 + m * 16 + fr) * 1024 + col0;
#pragma unroll
            for (int bj = 0; bj < 2; ++bj)
#pragma unroll
                for (int n = 0; n < 2; ++n) pre[m][bj][n] = *(const pg8::f32x4*)(out + off + bj * 128 + n * 16); }
        st.run(acc, u, wr, wc, fr, fq, lds, wid, lane);
        pg8::f32x4 gv[2][2];
#pragma unroll
        for (int bj = 0; bj < 2; ++bj)
#pragma unroll
            for (int n = 0; n < 2; ++n) gv[bj][n] = *(const pg8::f32x4*)(g + col0 + bj * 128 + n * 16);
#pragma unroll
        for (int ai = 0; ai < 2; ++ai)
#pragma unroll
            for (int m = 0; m < 4; ++m) {
                const int r = ai * 128 + wr * 64 + m * 16 + fr; const float sr = S[r]; const size_t off = (size_t)(u.pm * 256 + r) * 1024 + col0;
#pragma unroll
                for (int bj = 0; bj < 2; ++bj)
#pragma unroll
                    for (int n = 0; n < 2; ++n) { float* op = out + off + bj * 128 + n * 16; const pg8::f32x4 xs = (ai == 0) ? pre[m][bj][n] : *(const pg8::f32x4*)op; *(pg8::f32x4*)op = xs + acc[ai][bj][m][n] * sr * gv[bj][n]; }
                if (m == 3) asm volatile("" ::: "memory");
            }
    }
};

template <int MODE> __device__ __forceinline__ void tr_item(const float* W, int pitch, int K, int k0, int n0, bf16* WT, int drow0, float* scr, int lane) {
    float tv[32];
#pragma unroll
    for (int i = 0; i < 32; ++i) { const int kk = 2 * i + (lane >> 5); tv[i] = W[(size_t)(k0 + kk) * pitch + n0 + (lane & 31)]; }
#pragma unroll
    for (int i = 0; i < 32; ++i) { const int kk = 2 * i + (lane >> 5); scr[kk * 33 + (lane & 31)] = tv[i]; }
    __builtin_amdgcn_fence(__ATOMIC_RELEASE, "workgroup"); asm volatile("s_waitcnt lgkmcnt(0)" ::: "memory");
    const int c = lane & 7;
#pragma unroll
    for (int j = 0; j < 4; ++j) {
        const int n = (lane >> 3) + 8 * j; const float* s = scr + (8 * c) * 33 + n;
        u32x4 o; o.x = pk2(s[0 * 33], s[1 * 33]); o.y = pk2(s[2 * 33], s[3 * 33]); o.z = pk2(s[4 * 33], s[5 * 33]); o.w = pk2(s[6 * 33], s[7 * 33]);
        const int drow = (MODE == 0) ? (drow0 + n) : (2 * (n0 + n) + drow0);
        *(u32x4*)(WT + (size_t)drow * K + k0 + 8 * c) = o;
    }
    asm volatile("s_waitcnt lgkmcnt(0)" ::: "memory");
}
struct KP {
    const float* in[21]; float* out; unsigned char* ws; int ph_lo, ph_hi;
};
typedef const __attribute__((address_space(4))) KP* KPC;

__device__ __forceinline__ void phase0(KPC p, unsigned char* lds, int tid, int lane, int wave) {
    float* scr = (float*)(lds + wave * 16384);
    const int gw = blockIdx.x * 8 + wave, NGW = gridDim.x * 8;
    unsigned char* ws = p->ws;
    const int seg_src[8] = {0, 512, 1024, 2048, 3088, 3600, 4392, 5416};
    const int seg_w[8] = {512, 512, 1024, 1024, 512, 768, 1024, 1024};
    const int seg_dst[8] = {0, 512, 1024, 2048, 3072, 3584, 4352, 5376};
    constexpr int I_IN = 16 * 200, I_W1 = 32 * 2;
    constexpr int NIT = I_IN + 2 * I_W1;
    for (int it = gw; it < NIT; it += NGW) {
        int r = it;
        if (r < I_IN) {
            const int seg_start[9] = {0, 256, 512, 1024, 1536, 1792, 2176, 2688, 3200};
            int sgi = 0;
#pragma unroll
            for (int s = 1; s < 8; ++s) sgi += (r >= seg_start[s]) ? 1 : 0;
            int src = 0, wdt = 32, dst = 0, accum = 0;
#pragma unroll
            for (int s = 0; s < 8; ++s) if (s == sgi) { src = seg_src[s]; wdt = seg_w[s]; dst = seg_dst[s]; accum = seg_start[s]; }
            const int li = r - accum, nblk = wdt / 32, kb = li / nblk, nb = li % nblk;
            tr_item<0>(p->in[5], 6440, 1024, kb * 64, src + nb * 32, (bf16*)(ws + WS_WIN), dst + nb * 32, scr, lane);
            continue;
        }
        r -= I_IN;
        if (r < I_W1) { const int kb = r / 2, nb = r % 2; tr_item<0>(p->in[10], 64, 2048, kb * 64, nb * 32, (bf16*)(ws + WS_W1T), nb * 32, scr, lane); continue; }
        r -= I_W1;
        { const int kb = r / 2, nb = r % 2; tr_item<0>(p->in[13], 64, 2048, kb * 64, nb * 32, (bf16*)(ws + WS_W1T) + 64 * 2048, nb * 32, scr, lane); }
    }
    {
        bf16* WT = (bf16*)(ws + WS_WIN);
        for (int idx = blockIdx.x * 512 + tid; idx < 40 * 1024; idx += gridDim.x * 512) {
            const int k = idx / 40, c = idx - k * 40;
            const int col = c < 16 ? 3072 + c : 4368 + (c - 16);
            WT[(size_t)(6400 + c) * 1024 + k] = f2bf(p->in[5][(size_t)k * 6440 + col]);
        }
        u32x4* Z = (u32x4*)(WT + (size_t)6440 * 1024);
        for (int idx = blockIdx.x * 512 + tid; idx < 216 * 128; idx += gridDim.x * 512) Z[idx] = (u32x4){0u, 0u, 0u, 0u};
    }
    if ((int)blockIdx.x >= (int)gridDim.x - 64) {
        const int u = (int)gridDim.x - 1 - (int)blockIdx.x, kv = u & 1, part = u >> 1, c = tid & 63, kk = tid >> 6;
        const float* pe = kv ? p->in[12] : p->in[9]; const float* w1 = kv ? p->in[13] : p->in[10];
        float sacc = 0.f;
#pragma unroll
        for (int e = 0; e < 8; ++e) { const int k = part * 64 + kk * 8 + e; sacc += pe[k] * w1[(size_t)k * 64 + c]; }
        float* red = (float*)(lds + 8 * 16384);
        red[kk * 64 + c] = sacc;
        __syncthreads();
        if (tid < 64) { float t = 0.f;
#pragma unroll
            for (int q = 0; q < 8; ++q) t += red[q * 64 + tid];
            ((float*)(ws + WS_PEW))[(kv * 32 + part) * 64 + tid] = t; }
        __syncthreads();
    }
    {
        const float* g1 = p->in[1]; bf16* XN = (bf16*)(ws + WS_XN);
        for (int row = gw; row < T_; row += 2 * NGW) {
            const f32x4* xr0 = (const f32x4*)(p->in[0] + (size_t)row * 1024) + lane;
            const f32x4* xr1 = (const f32x4*)(p->in[0] + (size_t)(row + NGW) * 1024) + lane;
            f32x4 v0[4], v1[4]; float s0 = 0.f, s1 = 0.f;
#pragma unroll
            for (int j = 0; j < 4; ++j) { v0[j] = xr0[64 * j]; v1[j] = xr1[64 * j]; }
#pragma unroll
            for (int j = 0; j < 4; ++j) { s0 += v0[j][0] * v0[j][0] + v0[j][1] * v0[j][1] + v0[j][2] * v0[j][2] + v0[j][3] * v0[j][3]; s1 += v1[j][0] * v1[j][0] + v1[j][1] * v1[j][1] + v1[j][2] * v1[j][2] + v1[j][3] * v1[j][3]; }
            const float rstd0 = rsqrtf(wave_sum(s0) * (1.f / 1024.f) + RMS_EPS), rstd1 = rsqrtf(wave_sum(s1) * (1.f / 1024.f) + RMS_EPS);
            u32x2* o0 = (u32x2*)(XN + (size_t)row * 1024) + lane; u32x2* o1 = (u32x2*)(XN + (size_t)(row + NGW) * 1024) + lane;
#pragma unroll
            for (int j = 0; j < 4; ++j) {
                const f32x4 g = ((const f32x4*)g1)[lane + 64 * j];
                u32x2 w; w.x = pk2(v0[j][0] * rstd0 * g[0], v0[j][1] * rstd0 * g[1]); w.y = pk2(v0[j][2] * rstd0 * g[2], v0[j][3] * rstd0 * g[3]);
                o0[64 * j] = w;
                w.x = pk2(v1[j][0] * rstd1 * g[0], v1[j][1] * rstd1 * g[1]); w.y = pk2(v1[j][2] * rstd1 * g[2], v1[j][3] * rstd1 * g[3]);
                o1[64 * j] = w;
            }
        }
    }
}

__device__ __forceinline__ void compress_unit(KPC p, unsigned char* lds, int unit, int tid, int lane, int wave) {
    unsigned char* ws = p->ws;
    const int kvsel = unit >> 6, bg = (unit >> 3) & 7, rb = unit & 7, b = bg >> 1, g = bg & 1;
    const int r32 = lane & 31, hi = lane >> 5;
    const bf16* NKV = (const bf16*)(ws + WS_NKV);
    const bf16* W1T = (const bf16*)(ws + WS_W1T) + (size_t)kvsel * 64 * 2048;
    const int nrow = rb * 32 + r32, nld = nrow < 255 ? nrow : 254;
    f32x16 c0, c1;
#pragma unroll
    for (int r = 0; r < 16; ++r) { c0[r] = 0.f; c1[r] = 0.f; }
#pragma unroll
    for (int l4 = 0; l4 < 4; ++l4) {
        const int l = 4 * wave + l4;
        const size_t trow = (size_t)b * S_ + 16 * nld + l;
#pragma unroll
        for (int d0 = 0; d0 < 4; ++d0) {
            const bf16x8 a = *(const bf16x8*)(NKV + trow * 768 + kvsel * 128 + g * 64 + d0 * 16 + hi * 8);
            const int k = l * 64 + d0 * 16 + hi * 8;
            const bf16x8 b0 = *(const bf16x8*)(W1T + (size_t)r32 * 2048 + k);
            const bf16x8 b1 = *(const bf16x8*)(W1T + (size_t)(32 + r32) * 2048 + k);
            c0 = MFMA32(a, b0, c0); c1 = MFMA32(a, b1, c1);
        }
    }
    float* part = (float*)lds;
    float* H = (float*)(lds + 65536);
    float* W2s = (float*)(lds + 73728);
    { const float* w2g = kvsel ? p->in[14] : p->in[11];
#pragma unroll
      for (int e = 0; e < 8; ++e) W2s[tid + 512 * e] = w2g[tid + 512 * e]; }
#pragma unroll
    for (int r = 0; r < 16; ++r) { part[wave * 2048 + crow(r, hi) * 64 + r32] = c0[r]; part[wave * 2048 + crow(r, hi) * 64 + 32 + r32] = c1[r]; }
    __syncthreads();
    const float* PEW = (const float*)(ws + WS_PEW) + kvsel * 2048;
#pragma unroll
    for (int e = 0; e < 4; ++e) {
        const int idx = tid + 512 * e; float s = 0.f;
#pragma unroll 8
        for (int pi = 0; pi < 32; ++pi) s += PEW[pi * 64 + (idx & 63)];
#pragma unroll
        for (int w = 0; w < 8; ++w) s += part[w * 2048 + idx];
        H[idx] = siluf_(s);
    }
    __syncthreads();
    const float* w2 = kvsel ? p->in[14] : p->in[11];
    bf16* OUT = (bf16*)(ws + (kvsel ? WS_VCB : WS_KCB)) + (size_t)bg * 256 * 64;
#pragma unroll
    for (int e = 0; e < 4; ++e) {
        const int idx = tid + 512 * e, i = idx >> 6, c2 = idx & 63; float s = 0.f;
        for (int c = 0; c < 64; ++c) s += H[i * 64 + c] * W2s[c * 64 + c2];
        const int n = rb * 32 + i;
        if (kvsel == 0) OUT[(size_t)n * 64 + c2] = n < 255 ? f2bf(s) : (bf16)0;
        else OUT[(size_t)((n >> 6) * 64 + c2) * 64 + (n & 63)] = n < 255 ? f2bf(s) : (bf16)0;
    }
    __syncthreads();
}

__device__ __forceinline__ void gla_prep_unit(KPC p, unsigned char* lds, int unit, int tid, int lane, int wave) {
    unsigned char* ws = p->ws;
    const int n = unit & 63, b = unit >> 6;
    const size_t tr0 = (size_t)b * S_ + n * 64;
    const bf16* GSM = (const bf16*)(ws + WS_GSM);
    bf16* GQ = (bf16*)(ws + WS_GQ); bf16* GK = (bf16*)(ws + WS_GK); bf16* KD = (bf16*)(ws + WS_KD);
    {
        bf16* gv = (bf16*)(ws + WS_GV) + tr0 * 1024;
        u32x4 v0[8], v1[8];
#pragma unroll
        for (int e = 0; e < 8; ++e) { v0[e] = *(const u32x4*)(gv + (size_t)lane * 1024 + (2 * wave) * 64 + e * 8); v1[e] = *(const u32x4*)(gv + (size_t)lane * 1024 + (2 * wave + 1) * 64 + e * 8); }
        asm volatile("s_waitcnt vmcnt(0)" ::: "memory");
        __syncthreads();
        bf16* scr = (bf16*)(lds + wave * 8448); unsigned* s32 = (unsigned*)scr;
#pragma unroll
        for (int t = 0; t < 2; ++t) {
#pragma unroll
            for (int e = 0; e < 8; ++e) { const u32x4 v = t ? v1[e] : v0[e]; s32[lane * 33 + e * 4 + 0] = v.x; s32[lane * 33 + e * 4 + 1] = v.y; s32[lane * 33 + e * 4 + 2] = v.z; s32[lane * 33 + e * 4 + 3] = v.w; }
            __builtin_amdgcn_fence(__ATOMIC_RELEASE, "workgroup"); asm volatile("s_waitcnt lgkmcnt(0)" ::: "memory");
            bf16* dst = gv + (size_t)((2 * wave + t) * 64 + lane) * 64;
#pragma unroll
            for (int e = 0; e < 8; ++e) {
                unsigned w[4];
#pragma unroll
                for (int k = 0; k < 4; ++k) { const unsigned lo = scr[(e * 8 + 2 * k) * 66 + lane], hi = scr[(e * 8 + 2 * k + 1) * 66 + lane]; w[k] = lo | (hi << 16); }
                *(u32x4*)(dst + e * 8) = (u32x4){w[0], w[1], w[2], w[3]};
            }
            asm volatile("s_waitcnt lgkmcnt(0)" ::: "memory");
        }
    }
    __syncthreads();
    float* BT = (float*)lds;
    float* TOT = (float*)(lds + 32768);
    bf16* KDS = (bf16*)(lds + 36864);
    const int d = tid & 127, cgp = tid >> 7;
    for (int h = 0; h < 4; ++h) {
        const int bh = b * 4 + h;
        {
            float wa[16];
#pragma unroll
            for (int r = 0; r < 16; ++r) wa[r] = p->in[6][r * 512 + h * 128 + d];
            const float ba = p->in[7][h * 128 + d];
            float bc[16]; float run = 0.f;
#pragma unroll
            for (int i = 0; i < 16; ++i) {
                const int c = cgp * 16 + i;
                const u32x4 g0 = *(const u32x4*)(GSM + (tr0 + c) * 64), g1 = *(const u32x4*)(GSM + (tr0 + c) * 64 + 8);
                float x = ba;
                x += bflo(g0.x) * wa[0] + bfhi(g0.x) * wa[1] + bflo(g0.y) * wa[2] + bfhi(g0.y) * wa[3] + bflo(g0.z) * wa[4] + bfhi(g0.z) * wa[5] + bflo(g0.w) * wa[6] + bfhi(g0.w) * wa[7];
                x += bflo(g1.x) * wa[8] + bfhi(g1.x) * wa[9] + bflo(g1.y) * wa[10] + bfhi(g1.y) * wa[11] + bflo(g1.z) * wa[12] + bfhi(g1.z) * wa[13] + bflo(g1.w) * wa[14] + bfhi(g1.w) * wa[15];
                const float ls = fminf(x, 0.f) - __logf(1.f + __expf(-fabsf(x)));
                run += ls * (1.f / 16.f);
                bc[i] = run;
            }
            TOT[cgp * 128 + d] = run;
            __syncthreads();
            float prefix = 0.f;
#pragma unroll
            for (int q = 0; q < 3; ++q) if (q < cgp) prefix += TOT[q * 128 + d];
#pragma unroll
            for (int i = 0; i < 16; ++i) BT[(cgp * 16 + i) * 128 + d] = bc[i] + prefix;
            if (cgp == 0) ((float*)(ws + WS_DEC))[(size_t)(bh * 64 + n) * 128 + d] = __expf((TOT[d] + TOT[128 + d]) + (TOT[256 + d] + TOT[384 + d]));
        }
        __syncthreads();
        {
            const int c = tid >> 3, ds = (tid & 7) * 16;
            const size_t o = (tr0 + c) * 512 + h * 128 + ds;
            const u32x4 q0 = *(const u32x4*)(GQ + o), q1 = *(const u32x4*)(GQ + o + 8), k0 = *(const u32x4*)(GK + o), k1 = *(const u32x4*)(GK + o + 8);
            const unsigned qw[8] = {q0.x, q0.y, q0.z, q0.w, q1.x, q1.y, q1.z, q1.w}, kw[8] = {k0.x, k0.y, k0.z, k0.w, k1.x, k1.y, k1.z, k1.w};
            unsigned qo[8], ko[8];
            const float qs = 0.08838834764831845f;
#pragma unroll
            for (int e = 0; e < 8; ++e) {
                float r[2][3];
#pragma unroll
                for (int z = 0; z < 2; ++z) {
                    const int dd = ds + 2 * e + z;
                    const float bb = BT[c * 128 + dd];
                    const float tt = (TOT[dd] + TOT[128 + dd]) + (TOT[256 + dd] + TOT[384 + dd]);
                    const float q = z ? bfhi(qw[e]) : bflo(qw[e]), k = z ? bfhi(kw[e]) : bflo(kw[e]);
                    const float eb = __expf(bb), ie = __expf(-bb);
                    r[z][0] = q * qs * eb; r[z][1] = k * ie; r[z][2] = k * __expf(tt - bb);
                    KDS[dd * 72 + (c ^ (((dd >> 4) & 7) << 3))] = f2bf(r[z][2]);
                }
                qo[e] = pk2(r[0][0], r[1][0]); ko[e] = pk2(r[0][1], r[1][1]);
            }
            *(u32x4*)(GQ + o) = (u32x4){qo[0], qo[1], qo[2], qo[3]}; *(u32x4*)(GQ + o + 8) = (u32x4){qo[4], qo[5], qo[6], qo[7]};
            *(u32x4*)(GK + o) = (u32x4){ko[0], ko[1], ko[2], ko[3]}; *(u32x4*)(GK + o + 8) = (u32x4){ko[4], ko[5], ko[6], ko[7]};
        }
        __syncthreads();
        {
            const int dk = tid >> 2, part = tid & 3;
            const int ksw = (dk >> 4) & 7;
            const u32x4 a0 = *(const u32x4*)(KDS + dk * 72 + (((2 * part) ^ ksw) << 3)), a1 = *(const u32x4*)(KDS + dk * 72 + (((2 * part + 1) ^ ksw) << 3));
            bf16* kdt = KD + ((size_t)(bh * 64 + n) * 128 + dk) * 64 + part * 16;
            *(u32x4*)kdt = a0; *(u32x4*)(kdt + 8) = a1;
        }
        __syncthreads();
    }
}
__device__ __forceinline__ void tile_transpose64(bf16* base, bf16* scr, int lane) {
    u32x4 v[8];
#pragma unroll
    for (int e = 0; e < 8; ++e) v[e] = *(const u32x4*)(base + (size_t)lane * 768 + e * 8);
    unsigned* s32 = (unsigned*)scr;
#pragma unroll
    for (int e = 0; e < 8; ++e) { s32[lane * 33 + e * 4 + 0] = v[e].x; s32[lane * 33 + e * 4 + 1] = v[e].y; s32[lane * 33 + e * 4 + 2] = v[e].z; s32[lane * 33 + e * 4 + 3] = v[e].w; }
    __builtin_amdgcn_fence(__ATOMIC_RELEASE, "workgroup"); asm volatile("s_waitcnt lgkmcnt(0)" ::: "memory");
#pragma unroll
    for (int e = 0; e < 8; ++e) {
        unsigned w[4];
#pragma unroll
        for (int k = 0; k < 4; ++k) { const unsigned lo = scr[(e * 8 + 2 * k) * 66 + lane], hi = scr[(e * 8 + 2 * k + 1) * 66 + lane]; w[k] = lo | (hi << 16); }
        *(u32x4*)(base + (size_t)lane * 768 + e * 8) = (u32x4){w[0], w[1], w[2], w[3]};
    }
    asm volatile("s_waitcnt lgkmcnt(0)" ::: "memory");
}

__device__ __forceinline__ void phase2(KPC p, unsigned char* lds, int tid, int lane, int wave) {
    for (int u = (int)gridDim.x - 1 - (int)blockIdx.x; u < 128; u += gridDim.x) compress_unit(p, lds, u, tid, lane, wave);
    for (int u = blockIdx.x; u < 256; u += gridDim.x) gla_prep_unit(p, lds, u, tid, lane, wave);
    __syncthreads();
    {
        bf16* scrw = (bf16*)(lds + wave * 8448);
        const int gw0 = blockIdx.x * 8 + wave, NGW0 = gridDim.x * 8;
        for (int t = gw0; t < 1024; t += NGW0) {
            const int which = t & 1, g = (t >> 1) & 1, j = (t >> 2) & 63, b = t >> 8;
            tile_transpose64((bf16*)(p->ws + WS_NKV) + ((size_t)b * S_ + j * 64) * 768 + (which ? 640 : 384) + g * 64, scrw, lane);
        }
    }
    __syncthreads();
}

constexpr int GL_QE = 0, GL_KE = 17408, GL_KDT = 34816, GL_VT = 53248, GL_PS = 90112, GL_OST = 99328, GL_DEC = 133120;
constexpr size_t WS_SLOC = 44 * MiB, WS_DTOT = 52 * MiB;
constexpr int CTL_FLAG = 128;
__device__ __forceinline__ void gla_block(KPC p, unsigned char* lds, int bh, int seg, int tid, int lane, int wave, bool dostore = true, int fl = 0) {
    unsigned char* ws = p->ws;
    const int b = bh >> 2, h = bh & 3, r32 = lane & 31, hi = lane >> 5;
    bf16* QE = (bf16*)(lds + GL_QE); bf16* KE = (bf16*)(lds + GL_KE); bf16* KDT = (bf16*)(lds + GL_KDT); bf16* VT = (bf16*)(lds + GL_VT);
    bf16* PS = (bf16*)(lds + GL_PS); bf16* OST = (bf16*)(lds + GL_OST); float* DECS = (float*)(lds + GL_DEC);
    const bf16* gQ = (const bf16*)(ws + WS_GQ); const bf16* gK = (const bf16*)(ws + WS_GK); const bf16* gD = (const bf16*)(ws + WS_KD);
    const bf16* gV = (const bf16*)(ws + WS_GV); bf16* gR = (bf16*)(ws + WS_GR); const float* gDec = (const float*)(ws + WS_DEC);
    float* SLOC = (float*)(ws + WS_SLOC); float* DTOT = (float*)(ws + WS_DTOT);
    unsigned* FLAG = (unsigned*)(ws + WS_CTL) + CTL_FLAG + fl;
    const float* normg = p->in[8];
    const int lrow = tid >> 3, seg8 = tid & 7;
    const int n0 = seg * 16;
    f32x16 S[4];
#pragma unroll
    for (int i = 0; i < 4; ++i)
#pragma unroll
        for (int r = 0; r < 16; ++r) S[i][r] = 0.f;
    u32x4 rq[2], rk[2], rd[2], rv[4]; float rdec = 0.f;
#define GLA_PF_LIGHT(n_) do { \
        const bf16* kd_ = gD + ((size_t)(bh * 64 + (n_)) * 128 + (tid >> 2)) * 64 + (tid & 3) * 16; \
        rd[0] = *(const u32x4*)kd_; rd[1] = *(const u32x4*)(kd_ + 8); \
        const bf16* vt_ = gV + ((size_t)b * S_ + (n_) * 64) * 1024 + ((size_t)(h * 256 + (tid >> 1))) * 64 + (tid & 1) * 32; \
        rv[0] = *(const u32x4*)vt_; rv[1] = *(const u32x4*)(vt_ + 8); rv[2] = *(const u32x4*)(vt_ + 16); rv[3] = *(const u32x4*)(vt_ + 24); \
        if (tid < 128) rdec = gDec[(size_t)(bh * 64 + (n_)) * 128 + tid]; } while (0)
#define GLA_PF_QK(n_) do { const size_t o_ = ((size_t)b * S_ + (n_) * 64 + lrow) * 512 + h * 128 + seg8 * 16; \
        rq[0] = *(const u32x4*)(gQ + o_); rq[1] = *(const u32x4*)(gQ + o_ + 8); rk[0] = *(const u32x4*)(gK + o_); rk[1] = *(const u32x4*)(gK + o_ + 8); } while (0)
#define GLA_ST_LIGHT() do { \
        bf16* kl_ = KDT + (tid >> 2) * 72 + (tid & 3) * 16; *(u32x4*)kl_ = rd[0]; *(u32x4*)(kl_ + 8) = rd[1]; \
        bf16* vl_ = VT + (tid >> 1) * 72 + (tid & 1) * 32; *(u32x4*)vl_ = rv[0]; *(u32x4*)(vl_ + 8) = rv[1]; *(u32x4*)(vl_ + 16) = rv[2]; *(u32x4*)(vl_ + 24) = rv[3]; \
        if (tid < 128) DECS[tid] = rdec; } while (0)
#define GLA_ST_QK() do { \
        *(u32x4*)(QE + lrow * 136 + seg8 * 16) = rq[0]; *(u32x4*)(QE + lrow * 136 + seg8 * 16 + 8) = rq[1]; \
        *(u32x4*)(KE + lrow * 136 + seg8 * 16) = rk[0]; *(u32x4*)(KE + lrow * 136 + seg8 * 16 + 8) = rk[1]; } while (0)
#define GLA_SUPDATE() do { \
        _Pragma("unroll") for (int i = 0; i < 4; ++i) { \
            _Pragma("unroll") for (int q4 = 0; q4 < 4; ++q4) { const f32x4 dv = *(const f32x4*)(DECS + 32 * i + 8 * q4 + 4 * hi); \
                S[i][4 * q4 + 0] *= dv[0]; S[i][4 * q4 + 1] *= dv[1]; S[i][4 * q4 + 2] *= dv[2]; S[i][4 * q4 + 3] *= dv[3]; } } \
        _Pragma("unroll") for (int ks = 0; ks < 4; ++ks) { \
            _Pragma("unroll") for (int i = 0; i < 4; ++i) { const bf16x8 ka = *(const bf16x8*)(KDT + (32 * i + r32) * 72 + 16 * ks + 8 * hi); S[i] = MFMA32(ka, vb[ks], S[i]); } } } while (0)
    if (seg < 3) {
        float dprod = 1.f;
        GLA_PF_LIGHT(n0); GLA_ST_LIGHT();
        __syncthreads();
#pragma unroll 1
        for (int n = n0; n < n0 + 16; ++n) {
            if (n + 1 < n0 + 16) GLA_PF_LIGHT(n + 1);
            if (tid < 128) dprod *= DECS[tid];
            bf16x8 vb[4];
#pragma unroll
            for (int ks = 0; ks < 4; ++ks) vb[ks] = *(const bf16x8*)(VT + (32 * wave + r32) * 72 + 16 * ks + 8 * hi);
            GLA_SUPDATE();
            __syncthreads();
            if (n + 1 < n0 + 16) { GLA_ST_LIGHT(); }
            __syncthreads();
        }
        float* sl = SLOC + (size_t)(bh * 4 + seg) * 32768 + 32 * wave + r32;
#pragma unroll
        for (int i = 0; i < 4; ++i)
#pragma unroll
            for (int r = 0; r < 16; ++r) sl[(size_t)(32 * i + crow(r, hi)) * 256] = S[i][r];
        if (tid < 128) DTOT[(bh * 4 + seg) * 128 + tid] = dprod;
        asm volatile("s_waitcnt vmcnt(0)" ::: "memory");
        __syncthreads();
        if (tid == 0) {
            __builtin_amdgcn_fence(__ATOMIC_RELEASE, "agent");
            asm volatile("s_waitcnt vmcnt(0)" ::: "memory");
            __hip_atomic_store(FLAG + bh * 4 + seg, 1u, __ATOMIC_RELAXED, __HIP_MEMORY_SCOPE_AGENT);
        }
    }
#pragma unroll
    for (int i = 0; i < 4; ++i)
#pragma unroll
        for (int r = 0; r < 16; ++r) S[i][r] = 0.f;
    if (seg > 0) {
        if (tid == 0) {
            for (int s2 = 0; s2 < seg; ++s2) {
                unsigned spins = 0;
                while (__hip_atomic_load(FLAG + bh * 4 + s2, __ATOMIC_RELAXED, __HIP_MEMORY_SCOPE_AGENT) == 0u) { __builtin_amdgcn_s_sleep(4); if (++spins > (1u << 22)) break; }
            }
            __builtin_amdgcn_fence(__ATOMIC_ACQUIRE, "agent");
            asm volatile("s_waitcnt vmcnt(0)" ::: "memory");
        }
        __syncthreads();
#pragma unroll 1
        for (int s2 = 0; s2 < seg; ++s2) {
            const float* sl = SLOC + (size_t)(bh * 4 + s2) * 32768 + 32 * wave + r32;
            const float* dt = DTOT + (bh * 4 + s2) * 128;
#pragma unroll
            for (int i = 0; i < 4; ++i)
#pragma unroll
                for (int r = 0; r < 16; ++r) { const int dk = 32 * i + crow(r, hi);
                    const float dd = __hip_atomic_load(dt + dk, __ATOMIC_RELAXED, __HIP_MEMORY_SCOPE_AGENT), sv = __hip_atomic_load(sl + (size_t)dk * 256, __ATOMIC_RELAXED, __HIP_MEMORY_SCOPE_AGENT);
                    S[i][r] = dd * S[i][r] + sv; }
        }
    }
    GLA_PF_LIGHT(n0); GLA_PF_QK(n0);
    __syncthreads();
    GLA_ST_LIGHT(); GLA_ST_QK();
    __syncthreads();
#pragma unroll 1
    for (int n = n0; n < n0 + 16; ++n) {
        if (n + 1 < n0 + 16) { GLA_PF_LIGHT(n + 1); GLA_PF_QK(n + 1); }
        if (wave < 4) {
            const int ci = wave >> 1, si = wave & 1;
            f32x16 pc;
#pragma unroll
            for (int r = 0; r < 16; ++r) pc[r] = 0.f;
            if (si <= ci) {
#pragma unroll
                for (int kk = 0; kk < 8; ++kk) {
                    const bf16x8 a = *(const bf16x8*)(QE + (32 * ci + r32) * 136 + 16 * kk + 8 * hi);
                    const bf16x8 bb = *(const bf16x8*)(KE + (32 * si + r32) * 136 + 16 * kk + 8 * hi);
                    pc = MFMA32(a, bb, pc);
                }
            }
            const int s_idx = 32 * si + r32;
#pragma unroll
            for (int r = 0; r < 16; ++r) { const int c = 32 * ci + crow(r, hi); PS[c * 72 + s_idx] = f2bf(s_idx <= c ? pc[r] : 0.f); }
        }
        f32x16 o[2];
#pragma unroll
        for (int r = 0; r < 16; ++r) { o[0][r] = 0.f; o[1][r] = 0.f; }
#pragma unroll
        for (int i = 0; i < 4; ++i)
#pragma unroll
            for (int mm = 0; mm < 2; ++mm) {
                u32x4 sb; sb.x = pk2(S[i][8 * mm + 0], S[i][8 * mm + 1]); sb.y = pk2(S[i][8 * mm + 2], S[i][8 * mm + 3]); sb.z = pk2(S[i][8 * mm + 4], S[i][8 * mm + 5]); sb.w = pk2(S[i][8 * mm + 6], S[i][8 * mm + 7]);
                const bf16x8 bfr = __builtin_bit_cast(bf16x8, sb);
#pragma unroll
                for (int ch = 0; ch < 2; ++ch) {
                    const bf16* ap = QE + (32 * ch + r32) * 136 + 32 * i + 16 * mm + 4 * hi;
                    const bf16x8 a = mk8(*(const u32x2*)ap, *(const u32x2*)(ap + 8));
                    o[ch] = MFMA32(a, bfr, o[ch]);
                }
            }
        __syncthreads();
        bf16x8 vb[4];
#pragma unroll
        for (int ks = 0; ks < 4; ++ks) vb[ks] = *(const bf16x8*)(VT + (32 * wave + r32) * 72 + 16 * ks + 8 * hi);
#pragma unroll
        for (int ch = 0; ch < 2; ++ch)
#pragma unroll
            for (int ks = 0; ks < 4; ++ks) {
                const bf16x8 pa = *(const bf16x8*)(PS + (32 * ch + r32) * 72 + 16 * ks + 8 * hi);
                o[ch] = MFMA32(pa, vb[ks], o[ch]);
            }
        GLA_SUPDATE();
#pragma unroll
        for (int ch = 0; ch < 2; ++ch)
#pragma unroll
            for (int r = 0; r < 16; ++r) OST[(32 * ch + crow(r, hi)) * 264 + 32 * wave + r32] = f2bf(o[ch][r]);
        __syncthreads();
        if (n + 1 < n0 + 16) { GLA_ST_LIGHT(); GLA_ST_QK(); }
        {
            const bf16* op = OST + lrow * 264 + seg8 * 32;
            float ov[32];
#pragma unroll
            for (int e = 0; e < 4; ++e) {
                const u32x4 w = *(const u32x4*)(op + 8 * e);
                ov[8 * e + 0] = bflo(w.x); ov[8 * e + 1] = bfhi(w.x); ov[8 * e + 2] = bflo(w.y); ov[8 * e + 3] = bfhi(w.y);
                ov[8 * e + 4] = bflo(w.z); ov[8 * e + 5] = bfhi(w.z); ov[8 * e + 6] = bflo(w.w); ov[8 * e + 7] = bfhi(w.w);
            }
            float ss = 0.f;
#pragma unroll
            for (int e = 0; e < 32; ++e) ss += ov[e] * ov[e];
            ss += __shfl_xor(ss, 1); ss += __shfl_xor(ss, 2); ss += __shfl_xor(ss, 4);
            const float rstd = rsqrtf(ss * (1.f / 256.f) + RMS_EPS);
            bf16* rp = gR + ((size_t)b * S_ + n * 64 + lrow) * 1536 + h * 256 + seg8 * 32;
#pragma unroll
            for (int e = 0; e < 4; ++e) {
                const u32x4 rw = *(const u32x4*)(rp + 8 * e);
                const f32x4 g0 = *(const f32x4*)(normg + seg8 * 32 + 8 * e), g1 = *(const f32x4*)(normg + seg8 * 32 + 8 * e + 4);
                u32x4 w;
                w.x = pk2(ov[8 * e + 0] * rstd * g0[0] * siluf_(bflo(rw.x)), ov[8 * e + 1] * rstd * g0[1] * siluf_(bfhi(rw.x)));
                w.y = pk2(ov[8 * e + 2] * rstd * g0[2] * siluf_(bflo(rw.y)), ov[8 * e + 3] * rstd * g0[3] * siluf_(bfhi(rw.y)));
                w.z = pk2(ov[8 * e + 4] * rstd * g1[0] * siluf_(bflo(rw.z)), ov[8 * e + 5] * rstd * g1[1] * siluf_(bfhi(rw.z)));
                w.w = pk2(ov[8 * e + 6] * rstd * g1[2] * siluf_(bflo(rw.w)), ov[8 * e + 7] * rstd * g1[3] * siluf_(bfhi(rw.w)));
                if (dostore) *(u32x4*)(rp + 8 * e) = w;
            }
        }
        __syncthreads();
    }
#undef GLA_PF_LIGHT
#undef GLA_PF_QK
#undef GLA_ST_LIGHT
#undef GLA_ST_QK
#undef GLA_SUPDATE
}

constexpr int NS_KS = 0, NS_VT = 18432, NS_IMP = 36864, NS_SEL = 103424, NS_SCR = 103936, NS_NEED = 104960, NS_LIST = 105088, NS_UNIT = 105344;
struct NsaSt { float m, l; };
template <int KIND>
__device__ __forceinline__ int nsa_pass(unsigned char* lds, int ntiles, int tfirst, const bf16* Kb, const bf16* Vb, int pitch,
                                         const bf16x8 (&qr)[4], float sl2, int ql, int cur, int head, float& m, float& l, f32x16 (&o)[2],
                                         float mfix, float invl, int tid, int lane, int wave,
                                         bool pre, int b0, const bf16* nK, const bf16* nV, int npitch) {
    const int r32 = lane & 31, hi = lane >> 5;
    const int lrow = tid >> 3, ch = tid & 7;
    const int* tlist = (const int*)(lds + NS_LIST);
    float* scr = (float*)(lds + NS_SCR) + wave * 32;
    const unsigned long long selm = (KIND == 2) ? ((const unsigned long long*)(lds + NS_SEL))[ql] : 0ull;
    float* imp = (float*)(lds + NS_IMP) + ((size_t)head * 64 + ql) * 65;
    u32x4 kreg, vreg;
#define NS_TID(i_) ((KIND == 2) ? tlist[(i_)] : ((KIND == 3) ? (tfirst - (i_)) : (tfirst + (i_))))
#define NS_LOAD(i_) do { const int j_ = NS_TID(i_); const size_t ro_ = (size_t)(j_ * 64 + lrow) * pitch + ch * 8; kreg = *(const u32x4*)(Kb + ro_); vreg = *(const u32x4*)(Vb + ro_); } while (0)
#define NS_TW(base_, w_) do { const unsigned w__ = (w_); vt_[(base_) * 68 + lrow] = (bf16)(w__ & 0xffffu); vt_[((base_) + 1) * 68 + lrow] = (bf16)(w__ >> 16); } while (0)
#define NS_STORE(buf_) do { bf16* ks_ = (bf16*)(lds + NS_KS + (buf_) * 9216); bf16* vt_ = (bf16*)(lds + NS_VT + (buf_) * 9216); \
        *(u32x4*)(ks_ + lrow * 72 + ch * 8) = kreg; *(u32x4*)(vt_ + lrow * 72 + ch * 8) = vreg; } while (0)
    const float sstep = (KIND <= 1) ? 16.f * sl2 : sl2;
    f32x16 ci0, ci1;
#pragma unroll
    for (int r = 0; r < 16; ++r) { ci0[r] = sstep * (float)crow(r, hi); ci1[r] = ci0[r] + 32.f * sstep; }
    if (!pre) { NS_LOAD(0); NS_STORE(b0); __syncthreads(); }
    int buf = b0;
#pragma unroll 1
    for (int i = 0; i < ntiles; ++i) {
        const bool more = (i + 1 < ntiles);
        if (more) NS_LOAD(i + 1);
        else if (nK) { const size_t ro_ = (size_t)lrow * npitch + ch * 8; kreg = *(const u32x4*)(nK + ro_); vreg = *(const u32x4*)(nV + ro_); }
        const int j = NS_TID(i);
        const bf16* Ks = (const bf16*)(lds + NS_KS + buf * 9216); const bf16* VTs = (const bf16*)(lds + NS_VT + buf * 9216);
        f32x16 p0, p1;
#pragma unroll
        for (int d0 = 0; d0 < 4; ++d0) {
            const bf16x8 k0 = *(const bf16x8*)(Ks + r32 * 72 + d0 * 16 + hi * 8);
            const bf16x8 k1 = *(const bf16x8*)(Ks + (32 + r32) * 72 + d0 * 16 + hi * 8);
            if (d0 == 0) { p0 = MFMA32(k0, qr[0], ci0); p1 = MFMA32(k1, qr[0], ci1); }
            else { p0 = MFMA32(k0, qr[d0], p0); p1 = MFMA32(k1, qr[d0], p1); }
        }
        float cb; int limhi = 64, limlo = -1;
        if (KIND <= 1) { cb = sl2 * (float)(1024 * j + 31 - 64 * cur); limhi = ((64 * cur + ql - 31) >> 4) - 64 * j; }
        else {
            cb = sl2 * (float)(64 * (j - cur));
            if (KIND == 2) { if (!((selm >> j) & 1ull)) cb = -INFINITY; }
            if (j == cur) limhi = ql;
            if (KIND == 3 && j == cur - 8) limlo = ql;
        }
        if (__any(limhi < 63 || limlo >= 0)) {
#pragma unroll
            for (int r = 0; r < 16; ++r) { const int kv = crow(r, hi);
                if (kv > limhi || kv <= limlo) p0[r] = -INFINITY;
                if (kv + 32 > limhi || kv + 32 <= limlo) p1[r] = -INFINITY; }
        }
        float muse;
        if (KIND == 1) muse = mfix;
        else {
            float mx = fmaxf(p0[0], p1[0]);
#pragma unroll
            for (int r = 1; r < 16; ++r) mx = fmaxf(fmaxf(mx, p0[r]), p1[r]);
            mx += cb;
            mx = fmaxf(mx, __shfl_xor(mx, 32));
            const float mnew = (KIND >= 2 && !__any(mx > m + 8.f)) ? m : fmaxf(m, mx);
            muse = (mnew == -INFINITY) ? 0.f : mnew;
            const float alpha = __builtin_amdgcn_exp2f(m - muse);
            m = mnew;
            l *= alpha;
            if (KIND >= 2) {
                if (!__all(alpha == 1.f)) {
                    if (hi == 0) scr[r32] = alpha;
                    __builtin_amdgcn_fence(__ATOMIC_RELEASE, "workgroup"); asm volatile("s_waitcnt lgkmcnt(0)" ::: "memory");
#pragma unroll
                    for (int q4 = 0; q4 < 4; ++q4) {
                        const f32x4 av = *(const f32x4*)(scr + 8 * q4 + 4 * hi);
#pragma unroll
                        for (int e = 0; e < 4; ++e) { o[0][4 * q4 + e] *= av[e]; o[1][4 * q4 + e] *= av[e]; }
                    }
                    asm volatile("s_waitcnt lgkmcnt(0)" ::: "memory");
                }
            }
        }
        float ls = 0.f;
        const float base = cb - muse;
        if (KIND == 0) {
#pragma unroll
            for (int r = 0; r < 16; ++r) { p0[r] = __builtin_amdgcn_exp2f(p0[r] + base); p1[r] = __builtin_amdgcn_exp2f(p1[r] + base); ls += p0[r] + p1[r]; }
            l += ls;
        } else {
#pragma unroll
            for (int ks = 0; ks < 4; ++ks) {
                f32x16& P = (ks < 2) ? p0 : p1;
                const int rb = (ks & 1) * 8;
#pragma unroll
                for (int e = 0; e < 8; ++e) { float v = __builtin_amdgcn_exp2f(P[rb + e] + base); if (KIND == 1) v *= invl; P[rb + e] = v; ls += v; }
                u32x4 w; w.x = pk2(P[rb + 0], P[rb + 1]); w.y = pk2(P[rb + 2], P[rb + 3]); w.z = pk2(P[rb + 4], P[rb + 5]); w.w = pk2(P[rb + 6], P[rb + 7]);
                const bf16x8 pa = __builtin_bit_cast(bf16x8, w);
#pragma unroll
                for (int db = 0; db < 2; ++db) {
                    const bf16* vp = VTs + (db * 32 + r32) * 72 + 16 * ks + 4 * hi;
                    const bf16x8 vf = mk8(*(const u32x2*)vp, *(const u32x2*)(vp + 8));
                    o[db] = MFMA32(pa, vf, o[db]);
                }
            }
            if (KIND != 1) l += ls;
        }
        if (KIND == 1) {
#pragma unroll
            for (int a = 0; a < 4; ++a) {
                const int jb0 = 16 * j + 2 * a + hi, jb1 = jb0 + 8;
                imp[jb0] += p0[4 * a] + p0[4 * a + 1] + p0[4 * a + 2] + 0.5f * p0[4 * a + 3];
                imp[jb1] += p1[4 * a] + p1[4 * a + 1] + p1[4 * a + 2] + 0.5f * p1[4 * a + 3];
            }
            __builtin_amdgcn_fence(__ATOMIC_RELEASE, "workgroup"); asm volatile("s_waitcnt lgkmcnt(0)" ::: "memory");
#pragma unroll
            for (int a = 0; a < 4; ++a) {
                const int jb0 = 16 * j + 2 * a + hi, jb1 = jb0 + 8;
                imp[jb0 + 1] += 0.5f * p0[4 * a + 3];
                imp[jb1 + 1] += 0.5f * p1[4 * a + 3];
            }
            __builtin_amdgcn_fence(__ATOMIC_RELEASE, "workgroup"); asm volatile("s_waitcnt lgkmcnt(0)" ::: "memory");
        }
        if (more || nK) NS_STORE(buf ^ 1);
        __syncthreads();
        buf ^= 1;
    }
    return buf;
#undef NS_TID
#undef NS_LOAD
#undef NS_TW
#undef NS_STORE
}

__device__ __forceinline__ void nsa_unit(KPC p, unsigned char* lds, int unit, int tid_in, int lane_in, int wave, bool dostore = true) {
    int lane = lane_in; asm volatile("" : "+v"(lane));
    const int tid = wave * 64 + lane;
    unsigned char* ws = p->ws;
    const int bg = unit & 7, cur = 63 - (unit >> 3), b = bg >> 1, g = bg & 1;
    const int r32 = lane & 31, hi = lane >> 5, head = wave >> 1, ql = (wave & 1) * 32 + r32, hg = g * 4 + head;
    const size_t trow = (size_t)b * S_ + cur * 64 + ql;
    bf16* NQ = (bf16*)(ws + WS_GR) + 1024;
    const bf16* NKV = (const bf16*)(ws + WS_NKV) + (size_t)b * S_ * 768 + g * 64;
    const bf16* KCB = (const bf16*)(ws + WS_KCB) + (size_t)bg * 256 * 64; const bf16* VCB = (const bf16*)(ws + WS_VCB) + (size_t)bg * 256 * 64;
    const bf16* GSM = (const bf16*)(ws + WS_GSM);
    float* scr = (float*)(lds + NS_SCR) + wave * 32;
#define outp (NQ + ((size_t)b * S_ + cur * 64 + (wave & 1) * 32) * 1536 + hg * 64 + r32)
    bf16x8 qr[4];
#pragma unroll
    for (int d0 = 0; d0 < 4; ++d0) qr[d0] = *(const bf16x8*)(NQ + trow * 1536 + hg * 64 + d0 * 16 + hi * 8);
#define NS_GATE(k_) sigmoidf_(bf2f(GSM[((size_t)b * S_ + cur * 64 + ql) * 64 + 16 + hg * 3 + (k_)]))
    const float sl2 = exp2f(-(float)(hg + 1)) * LOG2E;
    { float* im = (float*)(lds + NS_IMP); for (int i = tid; i < 4 * 64 * 65; i += 512) im[i] = 0.f; }
    f32x16 o[2];
    float* accp = (float*)(lds + NS_IMP) + wave * 2048 + r32;
#define NS_FOLD(gk_, MODE_) do { \
        const float lt_ = l + __shfl_xor(l, 32); const float wq_ = lt_ > 0.f ? (gk_) / lt_ : 0.f; \
        if (hi == 0) scr[r32] = wq_; \
        __builtin_amdgcn_fence(__ATOMIC_RELEASE, "workgroup"); asm volatile("s_waitcnt lgkmcnt(0)" ::: "memory"); \
        _Pragma("unroll") for (int q4 = 0; q4 < 4; ++q4) { const f32x4 av = *(const f32x4*)(scr + 8 * q4 + 4 * hi); \
            _Pragma("unroll") for (int e = 0; e < 4; ++e) { const int r_ = 4 * q4 + e; const int ro_ = crow(r_, hi); \
                float a0_ = o[0][r_] * av[e], a1_ = o[1][r_] * av[e]; \
                if ((MODE_) >= 1) { a0_ += accp[ro_ * 64]; a1_ += accp[ro_ * 64 + 32]; } \
                if ((MODE_) <= 1) { accp[ro_ * 64] = a0_; accp[ro_ * 64 + 32] = a1_; } \
                else if (dostore) { outp[(size_t)ro_ * 1536] = f2bf(a0_); outp[(size_t)ro_ * 1536 + 32] = f2bf(a1_); } } } \
        asm volatile("s_waitcnt lgkmcnt(0)" ::: "memory"); } while (0)
#define NS_ZERO_O() do { _Pragma("unroll") for (int r = 0; r < 16; ++r) { o[0][r] = 0.f; o[1][r] = 0.f; } } while (0)
    float m, l;
    m = -INFINITY; l = 0.f; NS_ZERO_O();
    const int ncmp = ((4 * cur + 2) >> 6) + 1;
    int nb = nsa_pass<0>(lds, ncmp, 0, KCB, VCB, 64, qr, sl2, ql, cur, head, m, l, o, 0.f, 0.f, tid, lane, wave, false, 0, KCB, VCB, 64);
    {
        const float lt = l + __shfl_xor(l, 32);
        const float invl = lt > 0.f ? 1.f / lt : 0.f, mfix = (m == -INFINITY) ? 0.f : m;
        float m2 = m, l2 = 0.f;
        nb = nsa_pass<1>(lds, ncmp, 0, KCB, VCB, 64, qr, sl2, ql, cur, head, m2, l2, o, mfix, invl, tid, lane, wave, true, nb, NKV + 256 + (size_t)cur * 64 * 768, NKV + 384 + (size_t)cur * 64 * 768, 768);
    }
    {
        const float* im = (const float*)(lds + NS_IMP);
        unsigned long long* selp = (unsigned long long*)(lds + NS_SEL);
        unsigned long long uni = 0ull;
        const int jj = lane;
        const int nforced = cur == 0 ? 1 : (cur == 1 ? 2 : 3);
#pragma unroll 1
        for (int qi = 0; qi < 8; ++qi) {
            const int q = wave * 8 + qi;
            const float v = ((im[(0 * 64 + q) * 65 + jj] + im[(1 * 64 + q) * 65 + jj]) + im[(2 * 64 + q) * 65 + jj]) + im[(3 * 64 + q) * 65 + jj];
            const bool forced = (jj == 0) || (jj == cur) || (jj == cur - 1);
            const bool cand = (jj <= cur) && !forced;
            bool sel;
            if (cur + 1 <= 16) sel = (jj <= cur);
            else {
                const int K = 16 - nforced;
                const unsigned vb = __float_as_uint(v);
                unsigned T = 0u;
#pragma unroll 1
                for (int bit = 30; bit >= 0; --bit) {
                    const unsigned T2 = T | (1u << bit);
                    if (__popcll(__ballot(cand && vb >= T2)) >= K) T = T2;
                }
                const unsigned long long gt = __ballot(cand && vb > T), eq = __ballot(cand && vb == T);
                const int need = K - __popcll(gt);
                const int before = __popcll(eq & ((1ull << jj) - 1ull));
                sel = forced || (cand && (vb > T || (vb == T && before < need)));
            }
            const unsigned long long mk = __ballot(sel);
            if (lane == 0) selp[q] = mk;
            uni |= mk;
        }
        if (lane == 0) ((unsigned long long*)(lds + NS_NEED))[wave] = uni;
    }
    __syncthreads();
    int nsl = 0;
    {
        const unsigned long long* nd = (const unsigned long long*)(lds + NS_NEED);
        unsigned long long uni = 0ull;
#pragma unroll
        for (int w = 0; w < 8; ++w) uni |= nd[w];
        nsl = __popcll(uni);
        if (wave == 0) { int* tl = (int*)(lds + NS_LIST); const unsigned long long rest = uni & ~(1ull << cur);
            if (lane == 0) tl[0] = cur;
            if ((rest >> lane) & 1ull) tl[1 + __popcll(lane == 63 ? 0ull : (rest >> (lane + 1)))] = lane; }
    }
    __syncthreads();
    l = 0.5f; NS_FOLD(NS_GATE(0), 0);
    m = -INFINITY; l = 0.f; NS_ZERO_O();
    const int jfw = cur;
    nb = nsa_pass<2>(lds, nsl, 0, NKV + 256, NKV + 384, 768, qr, sl2, ql, cur, head, m, l, o, 0.f, 0.f, tid, lane, wave, true, nb, NKV + 512 + (size_t)jfw * 64 * 768, NKV + 640 + (size_t)jfw * 64 * 768, 768);
    NS_FOLD(NS_GATE(1), 1);
    m = -INFINITY; l = 0.f; NS_ZERO_O();
    {
        const int jf = cur - 8 < 0 ? 0 : cur - 8;
        nsa_pass<3>(lds, cur - jf + 1, cur, NKV + 512, NKV + 640, 768, qr, sl2, ql, cur, head, m, l, o, 0.f, 0.f, tid, lane, wave, true, nb, (const bf16*)nullptr, (const bf16*)nullptr, 0);
    }
    NS_FOLD(NS_GATE(2), 2);
    __syncthreads();
#undef NS_FOLD
#undef outp
#undef NS_GATE
#undef NS_ZERO_O
}

constexpr int LW_G = 16 * 88, LW_D = 44 * 32, LW_PG = 16 * 32, LW_PN = 8 * 32, LW_OUT = 16 * 32, LW_TOTAL = 2 * LW_G + LW_D + LW_PG + LW_PN + LW_OUT, LW_BLOCK_ITEMS = (LW_TOTAL + 7) / 8;
__device__ __forceinline__ void late_weight_item(KPC p, unsigned char* lds, int wi, int lane_in, int wave) {
    if (wi >= LW_TOTAL) return;
    int lane = lane_in; asm volatile("" : "+v"(lane));
    float* scr = (float*)(lds + wave * 16384);
    int r = wi;
    if (r < LW_G) { const int kb = r / 88, nb = r % 88; tr_item<1>(p->in[18], DFF_, 1024, kb * 64, nb * 32, (bf16*)(p->ws + WS_WGU), 0, scr, lane); return; }
    r -= LW_G;
    if (r < LW_G) { const int kb = r / 88, nb = r % 88; tr_item<1>(p->in[19], DFF_, 1024, kb * 64, nb * 32, (bf16*)(p->ws + WS_WGU), 1, scr, lane); return; }
    r -= LW_G;
    if (r < LW_D) { const int kb = r / 32, nb = r % 32; tr_item<0>(p->in[20], 1024, DFF_, kb * 64, nb * 32, (bf16*)(p->ws + WS_WD), nb * 32, scr, lane); return; }
    r -= LW_D;
    if (r < LW_PG) { const int kb = r / 32, nb = r % 32; tr_item<0>(p->in[15], 1024, 1536, kb * 64, nb * 32, (bf16*)(p->ws + WS_WPG), nb * 32, scr, lane); return; }
    r -= LW_PG;
    if (r < LW_PN) { const int kb = r / 32, nb = r % 32; tr_item<0>(p->in[16], 1024, 1536, kb * 64, nb * 32, (bf16*)(p->ws + WS_WPG) + 1024, nb * 32, scr, lane); return; }
    r -= LW_PN;
    { const int kb = r / 32, nb = r % 32; tr_item<0>(p->in[17], 1024, 1024, kb * 64, nb * 32, (bf16*)(p->ws + WS_WOUT), nb * 32, scr, lane); }
}

__device__ __forceinline__ void phase3(KPC p, unsigned char* lds, int tid, int lane, int wave) {
    const int NGLA = 16;
#if !(DIS & 1024)
    if ((int)blockIdx.x < 64) { if (DBL & 1024) gla_block(p, lds, blockIdx.x >> 2, blockIdx.x & 3, tid, lane, wave, false, 64); gla_block(p, lds, blockIdx.x >> 2, blockIdx.x & 3, tid, lane, wave); }
#endif
    unsigned* ctr = (unsigned*)(p->ws + WS_CTL);
    int* up = (int*)(lds + NS_UNIT);
    for (;;) {
        __syncthreads();
        if (tid == 0) *up = (int)atomicAdd(ctr, 1u);
        __syncthreads();
        const int u = *up;
        if (u >= 512 + LW_BLOCK_ITEMS) break;
        if (u >= 512) { late_weight_item(p, lds, (u - 512) * 8 + wave, lane, wave); continue; }
#if !(DIS & 2048)
        if (DBL & 2048) nsa_unit(p, lds, u, tid, lane, wave, false);
        nsa_unit(p, lds, u, tid, lane, wave);
#endif
    }
}

__device__ __forceinline__ void rowpass_a(KPC p, int lane, int wave) {
    const int gw = blockIdx.x * 8 + wave, NGW = gridDim.x * 8;
    const bf16* Y = (const bf16*)(p->ws + WS_Y); const float* SS = (const float*)(p->ws + WS_SS); bf16* XN2 = (bf16*)(p->ws + WS_XN2);
    const float* gpost = p->in[2]; const float* gpre2 = p->in[3];
    for (int row = gw; row < T_; row += NGW) {
        float s = lane < 16 ? SS[(size_t)row * 16 + lane] : 0.f;
        const float rstd = rsqrtf(wave_sum(s) * (1.f / 1024.f) + RMS_EPS);
        const u32x4 y0 = *(const u32x4*)(Y + (size_t)row * 1024 + lane * 16), y1 = *(const u32x4*)(Y + (size_t)row * 1024 + lane * 16 + 8);
        float yv[16] = {bflo(y0.x), bfhi(y0.x), bflo(y0.y), bfhi(y0.y), bflo(y0.z), bfhi(y0.z), bflo(y0.w), bfhi(y0.w),
                        bflo(y1.x), bfhi(y1.x), bflo(y1.y), bfhi(y1.y), bflo(y1.z), bfhi(y1.z), bflo(y1.w), bfhi(y1.w)};
        float x1[16]; float s2 = 0.f;
#pragma unroll
        for (int e = 0; e < 4; ++e) {
            const f32x4 xv = *(const f32x4*)(p->in[0] + (size_t)row * 1024 + lane * 16 + 4 * e);
            const f32x4 gv = *(const f32x4*)(gpost + lane * 16 + 4 * e);
            f32x4 r;
#pragma unroll
            for (int c = 0; c < 4; ++c) { r[c] = xv[c] + yv[4 * e + c] * rstd * gv[c]; x1[4 * e + c] = r[c]; s2 += r[c] * r[c]; }
            *(f32x4*)(p->out + (size_t)row * 1024 + lane * 16 + 4 * e) = r;
        }
        const float rstd2 = rsqrtf(wave_sum(s2) * (1.f / 1024.f) + RMS_EPS);
        u32x4 w0, w1;
        const f32x4 ga = *(const f32x4*)(gpre2 + lane * 16), gb = *(const f32x4*)(gpre2 + lane * 16 + 4), gc = *(const f32x4*)(gpre2 + lane * 16 + 8), gd = *(const f32x4*)(gpre2 + lane * 16 + 12);
        w0.x = pk2(x1[0] * rstd2 * ga[0], x1[1] * rstd2 * ga[1]); w0.y = pk2(x1[2] * rstd2 * ga[2], x1[3] * rstd2 * ga[3]);
        w0.z = pk2(x1[4] * rstd2 * gb[0], x1[5] * rstd2 * gb[1]); w0.w = pk2(x1[6] * rstd2 * gb[2], x1[7] * rstd2 * gb[3]);
        w1.x = pk2(x1[8] * rstd2 * gc[0], x1[9] * rstd2 * gc[1]); w1.y = pk2(x1[10] * rstd2 * gc[2], x1[11] * rstd2 * gc[3]);
        w1.z = pk2(x1[12] * rstd2 * gd[0], x1[13] * rstd2 * gd[1]); w1.w = pk2(x1[14] * rstd2 * gd[2], x1[15] * rstd2 * gd[3]);
        *(u32x4*)(XN2 + (size_t)row * 1024 + lane * 16) = w0; *(u32x4*)(XN2 + (size_t)row * 1024 + lane * 16 + 8) = w1;
    }
}
__device__ __forceinline__ void rowpass_b(KPC p, int lane, int wave) {
    const int gw = blockIdx.x * 8 + wave, NGW = gridDim.x * 8;
    const bf16* F = (const bf16*)(p->ws + WS_F); const float* SS = (const float*)(p->ws + WS_SS);
    const float* gpost = p->in[4];
    for (int row = gw; row < T_; row += NGW) {
        float s = lane < 16 ? SS[(size_t)row * 16 + lane] : 0.f;
        const float rstd = rsqrtf(wave_sum(s) * (1.f / 1024.f) + RMS_EPS);
        const u32x4 y0 = *(const u32x4*)(F + (size_t)row * 1024 + lane * 16), y1 = *(const u32x4*)(F + (size_t)row * 1024 + lane * 16 + 8);
        float yv[16] = {bflo(y0.x), bfhi(y0.x), bflo(y0.y), bfhi(y0.y), bflo(y0.z), bfhi(y0.z), bflo(y0.w), bfhi(y0.w),
                        bflo(y1.x), bfhi(y1.x), bflo(y1.y), bfhi(y1.y), bflo(y1.z), bfhi(y1.z), bflo(y1.w), bfhi(y1.w)};
#pragma unroll
        for (int e = 0; e < 4; ++e) {
            float* op = p->out + (size_t)row * 1024 + lane * 16 + 4 * e;
            const f32x4 xv = *(const f32x4*)op;
            const f32x4 gv = *(const f32x4*)(gpost + lane * 16 + 4 * e);
            f32x4 r;
#pragma unroll
            for (int c = 0; c < 4; ++c) r[c] = xv[c] + yv[4 * e + c] * rstd * gv[c];
            *(f32x4*)op = r;
        }
    }
}

#define XB_TMO      128
#define XB_XCNT(j)  (256  + 64 * (j))
#define XB_XSUB(j)  (1280 + 64 * (j))
#define XB_XGEN(j)  (2304 + 64 * (j))
#define XB_TOP      3328
#define XB_TOPGEN   3392
#define XCD_BAR_WORDS 3456
#define XB_SPIN_CAP (1u << 18)

__device__ __forceinline__ unsigned xb_ld(unsigned* p)              { return __hip_atomic_load(p, __ATOMIC_RELAXED, __HIP_MEMORY_SCOPE_AGENT); }
__device__ __forceinline__ unsigned xb_add(unsigned* p, unsigned v) { return __hip_atomic_fetch_add(p, v, __ATOMIC_RELAXED, __HIP_MEMORY_SCOPE_AGENT); }
__device__ __forceinline__ unsigned xb_xcc_id() { return (unsigned)__builtin_amdgcn_s_getreg((3 << 11) | 20) & 0xFu; }
#define XB_SPIN(cond, bar) do { unsigned _sp = 0; while (cond) { __builtin_amdgcn_s_sleep(1); \
    if ((++_sp & 255u) == 0u) { if (xb_ld(&(bar)[XB_TMO])) break; if (_sp > XB_SPIN_CAP) { atomicAdd(&(bar)[XB_TMO], 1u); break; } } } } while (0)

struct XcdBarrier {
    unsigned* bar; unsigned x;
    volatile PG8_LAS unsigned* st;
};

__device__ __forceinline__ XcdBarrier xcd_barrier_post(unsigned* bar, volatile PG8_LAS unsigned* st, bool leader) {
    XcdBarrier b; b.bar = bar; b.x = xb_xcc_id(); b.st = st;
    if (leader) (void)xb_add(&bar[XB_XCNT(b.x)], 1u);
    return b;
}
__device__ __forceinline__ void xcd_barrier_complete(unsigned* bar, unsigned x, unsigned& nloc, unsigned& nx) {
    const unsigned G = gridDim.x * gridDim.y * gridDim.z;
    unsigned sum, cnt, mine, sp = 0u;
    for (;;) {
        sum = 0u; cnt = 0u; mine = 0u;
#pragma unroll
        for (unsigned j = 0; j < 16; ++j) { const unsigned c = xb_ld(&bar[XB_XCNT(j)]); sum += c; cnt += (c > 0u) ? 1u : 0u; mine = (j == x) ? c : mine; }
        if (sum == G) break;
        __builtin_amdgcn_s_sleep(1);
        if ((++sp & 255u) == 0u) { if (xb_ld(&bar[XB_TMO])) break; if (sp > XB_SPIN_CAP) { atomicAdd(&bar[XB_TMO], 1u); break; } }
    }
    nloc = mine > 0u ? mine : 1u; nx = cnt > 0u ? cnt : 1u;
}

__device__ __forceinline__ void xcd_barrier(const XcdBarrier& b, bool leader) {
    asm volatile("s_waitcnt vmcnt(0)" ::: "memory");
    __syncthreads();
    if (leader) {
        unsigned* bar = b.bar;
        __builtin_amdgcn_s_waitcnt(0);
        unsigned nloc = b.st[0], nx = b.st[1];
        if (nloc == 0u) { xcd_barrier_complete(bar, b.x, nloc, nx); b.st[0] = nloc; b.st[1] = nx; }
        const unsigned old = xb_add(&bar[XB_XSUB(b.x)], 1u);
        const unsigned gen = old / nloc;
        if (old + 1u == (gen + 1u) * nloc) {
            __builtin_amdgcn_fence(__ATOMIC_RELEASE, "agent");
            asm volatile("s_waitcnt vmcnt(0)" ::: "memory");
            const unsigned og = xb_add(&bar[XB_TOP], 1u);
            const unsigned tg = og / nx;
            if (og + 1u == (tg + 1u) * nx) xb_add(&bar[XB_TOPGEN], 1u);
            else XB_SPIN(xb_ld(&bar[XB_TOPGEN]) == tg, bar);
            __builtin_amdgcn_fence(__ATOMIC_ACQUIRE, "agent");
            xb_add(&bar[XB_XGEN(b.x)], 1u);
            asm volatile("s_waitcnt vmcnt(0)" ::: "memory");
        } else {
            XB_SPIN(xb_ld(&bar[XB_XGEN(b.x)]) == gen, bar);
            __builtin_amdgcn_fence(__ATOMIC_ACQUIRE, "agent");
            asm volatile("s_waitcnt vmcnt(0)" ::: "memory");
        }
    }
    __syncthreads();
}

__device__ __forceinline__ void grid_bar(unsigned* bar, int wave, unsigned target) {
    asm volatile("s_waitcnt vmcnt(0) lgkmcnt(0)" ::: "memory");
    __syncthreads();
    if (wave == 0) {
        if ((int)__builtin_amdgcn_mbcnt_hi(~0u, __builtin_amdgcn_mbcnt_lo(~0u, 0u)) == 0) {
            __builtin_amdgcn_fence(__ATOMIC_RELEASE, "agent");
            asm volatile("s_waitcnt vmcnt(0)" ::: "memory");
            __hip_atomic_fetch_add(bar, 1u, __ATOMIC_RELAXED, __HIP_MEMORY_SCOPE_AGENT);
            unsigned spins = 0;
            while (__hip_atomic_load(bar, __ATOMIC_RELAXED, __HIP_MEMORY_SCOPE_AGENT) < target) { __builtin_amdgcn_s_sleep(2); if (++spins > (1u << 24)) break; }
            __builtin_amdgcn_fence(__ATOMIC_ACQUIRE, "agent");
            asm volatile("s_waitcnt vmcnt(0)" ::: "memory");
        }
    }
    __syncthreads();
}

constexpr int NPHASE = 10;
#ifndef LBN
#define LBN 2
#endif
__global__ void __launch_bounds__(512, LBN) fwd_kernel(KP pv) {
    KPC p = (KPC)__builtin_amdgcn_kernarg_segment_ptr();
    extern __shared__ __attribute__((aligned(16))) unsigned char lds[];
    const int wave = __builtin_amdgcn_readfirstlane(threadIdx.x >> 6);
#define lane ((int)__builtin_amdgcn_mbcnt_hi(~0u, __builtin_amdgcn_mbcnt_lo(~0u, 0u)))
#define tid (wave * 64 + lane)
    PG8_LAS unsigned char* ldsl = (PG8_LAS unsigned char*)lds;
    unsigned char* ws = p->ws;
    volatile PG8_LAS unsigned* xst = (volatile PG8_LAS unsigned*)(ldsl + 147440);
    if (wave == 0 && lane == 0) { xst[0] = 0u; xst[1] = 0u; }
    __syncthreads();
    const bool multi = (p->ph_hi - p->ph_lo) > 1;
    XcdBarrier xbar; xbar.bar = (unsigned*)(ws + WS_CTL) + 4096; xbar.x = 0; xbar.st = xst;
    if (multi) xbar = xcd_barrier_post((unsigned*)(ws + WS_CTL) + 4096, xst, wave == 0 && lane == 0);
    const int lo = p->ph_lo, hi = p->ph_hi;
    const bool fuse = multi && gridDim.x == 256;
#define IN(k) (lo <= (k) && (k) < hi)
#define SEAM(k) do { if (IN(k) && IN((k) + 1)) { xcd_barrier(xbar, wave == 0 && lane == 0); } } while (0)
    if (IN(0) && !(DIS & 1)) { phase0(p, lds, tid, lane, wave); if (DBL & 1) { __syncthreads(); phase0(p, lds, tid, lane, wave); } }
    SEAM(0);
    if (IN(1) && !(DIS & 2)) {
        pg8::Gemm g{(const bf16*)(ws + WS_XN), (const bf16*)(ws + WS_WIN), T_, NIN_, 1024}; pg8::StaticOrder S; S.init(T_, NIN_, gridDim.x, blockIdx.x);
        EpiIn E{ws};
        pg8::gemm_phase<EpiIn, pg8::StaticOrder, true, true>(ldsl, g, S, E, wave);
        if (DBL & 2) { __syncthreads(); pg8::gemm_phase<EpiIn, pg8::StaticOrder, true, true>(ldsl, g, S, E, wave); }
    }
    SEAM(1);
    if (IN(2) && !(DIS & 4)) phase2(p, lds, tid, lane, wave);
    SEAM(2);
    if (IN(3) && !(DIS & 8)) phase3(p, lds, tid, lane, wave);
    SEAM(3);
    if (IN(4) && !(DIS & 16)) {
        pg8::Gemm g{(const bf16*)(ws + WS_GR), (const bf16*)(ws + WS_WPG), T_, 1024, 1536}; pg8::StaticOrder S; S.init(T_, 1024, gridDim.x, blockIdx.x);
        EpiMixC E{(const bf16*)(ws + WS_MG), (const bf16*)(ws + WS_MN), (bf16*)(ws + WS_MIX)};
        pg8::gemm_phase<EpiMixC, pg8::StaticOrder, true, true>(ldsl, g, S, E, wave);
    }
    SEAM(4);
    if (IN(5) && !(DIS & 32)) {
        pg8::Gemm g{(const bf16*)(ws + WS_MIX), (const bf16*)(ws + WS_WOUT), T_, 1024, 1024}; pg8::StaticOrder S; S.init(T_, 1024, gridDim.x, blockIdx.x);
        if (fuse) {
            RmsPanel s1{(unsigned*)(ws + WS_XB), (unsigned*)(ws + WS_CTL) + CW_CNT}, s2{(unsigned*)(ws + WS_XB + 256 * 1024), (unsigned*)(ws + WS_CTL) + CW_CNT + 4096};
            EpiRmsResRms E{p->in[0], p->out, (bf16*)(ws + WS_XN2), p->in[2], p->in[3], s1, s2};
            pg8::gemm_phase<EpiRmsResRms, pg8::StaticOrder, false, true>(ldsl, g, S, E, wave);
        } else {
            EpiNorm E{(bf16*)(ws + WS_Y), (float*)(ws + WS_SS)};
            pg8::gemm_phase<EpiNorm, pg8::StaticOrder, true, true>(ldsl, g, S, E, wave);
        }
    }
    SEAM(5);
    if (!fuse) {
        if (IN(6) && !(DIS & 64)) rowpass_a(p, lane, wave);
        SEAM(6);
    }
    if (IN(7) && !(DIS & 128)) {
        pg8::Gemm g{(const bf16*)(ws + WS_XN2), (const bf16*)(ws + WS_WGU), T_, 2 * DFF_, 1024}; pg8::StaticOrder S; S.init(T_, 2 * DFF_, gridDim.x, blockIdx.x);
        EpiGU E{(bf16*)(ws + WS_HID)};
        pg8::gemm_phase<EpiGU, pg8::StaticOrder, true, true>(ldsl, g, S, E, wave);
        if (DBL & 128) { __syncthreads(); pg8::gemm_phase<EpiGU, pg8::StaticOrder, true, true>(ldsl, g, S, E, wave); }
    }
    SEAM(7);
    if (IN(8) && !(DIS & 256)) {
        pg8::Gemm g{(const bf16*)(ws + WS_HID), (const bf16*)(ws + WS_WD), T_, 1024, DFF_}; pg8::StaticOrder S; S.init(T_, 1024, gridDim.x, blockIdx.x);
        if (fuse) {
            RmsPanel s3{(unsigned*)(ws + WS_XB + 512 * 1024), (unsigned*)(ws + WS_CTL) + CW_CNT + 8192};
            EpiRmsRes E{p->out, p->in[4], s3};
            pg8::gemm_phase<EpiRmsRes, pg8::StaticOrder, false, true>(ldsl, g, S, E, wave);
        } else {
            EpiNorm E{(bf16*)(ws + WS_F), (float*)(ws + WS_SS)};
            pg8::gemm_phase<EpiNorm, pg8::StaticOrder, true, true>(ldsl, g, S, E, wave);
        }
    }
    if (!fuse) {
        SEAM(8);
        if (IN(9) && !(DIS & 512)) rowpass_b(p, lane, wave);
    }
#undef IN
#undef SEAM
#undef lane
#undef tid
}

#ifndef MK_SPLIT
#define MK_SPLIT 0
#endif
extern "C" void kernel_launch(void* const* d_in, const int* in_sizes, int n_in, void* d_out, int out_size, void* d_ws, size_t ws_size, hipStream_t stream) {
    static int grid = 0;
    if (grid == 0) {
        int dev = 0, cus = 0, per_cu = 0;
        hipGetDevice(&dev);
        hipDeviceGetAttribute(&cus, hipDeviceAttributeMultiprocessorCount, dev);
        if (hipFuncSetAttribute((const void*)fwd_kernel, hipFuncAttributeMaxDynamicSharedMemorySize, LDS_BYTES) != hipSuccess) { fprintf(stderr, "hipFuncSetAttribute failed\n"); }
        hipOccupancyMaxActiveBlocksPerMultiprocessor(&per_cu, (const void*)fwd_kernel, 512, LDS_BYTES);
        (void)hipGetLastError();
        if (per_cu < 1) per_cu = 1;
        grid = cus > 0 ? cus : 256;
        if (n_in != 21 || ws_size < 256 * MiB) fprintf(stderr, "kernel_launch: unexpected n_in %d / ws %zu\n", n_in, ws_size);
    }
    if (hipMemsetAsync((char*)d_ws + WS_CTL, 0, 98304, stream) != hipSuccess) fprintf(stderr, "memset failed\n");
    KP p{};
    for (int i = 0; i < 21; ++i) p.in[i] = (const float*)d_in[i];
    p.out = (float*)d_out; p.ws = (unsigned char*)d_ws;
#if MK_SPLIT
    for (int ph = 0; ph < NPHASE; ++ph) {
        p.ph_lo = ph; p.ph_hi = ph + 1;
        hipLaunchKernelGGL(fwd_kernel, dim3(grid), dim3(512), LDS_BYTES, stream, p);
    }
#else
    p.ph_lo = 0; p.ph_hi = NPHASE;
    void* args[] = {&p};
    hipError_t e = hipLaunchCooperativeKernel((const void*)fwd_kernel, dim3(grid), dim3(512), args, LDS_BYTES, stream);
    if (e != hipSuccess) fprintf(stderr, "cooperative launch failed: %s (grid %d)\n", hipGetErrorString(e), grid);
#endif
}
```
